# Optimizing an MI355X kernel written in HIP

```python
import jax, jax.numpy as jnp
from jax import lax
import numpy as np

D_MODEL = 1024
BATCH = 4
SEQ = 4096
DEPTH = 1
DEC_BATCH = 32
DEC_SEQ = 32
PAST_LEN = 2048

CHUNK = 64
BAND_CHUNKS = 8
WINDOW_A = BAND_CHUNKS * CHUNK
H_A = 8
HD_A = 64
MAX_REL = 128
H_B = 4
DK_B = 64
DV_B = 128
GK_RANK = 16
GK_NORM = 16.0
GLA_BLOCK = 16
D_FF = 2816
CONV_W = 3
EPS = 1e-6
NEG_INF = -1e30

W_A = H_A * HD_A
W_BK = H_B * DK_B
W_BV = H_B * DV_B
IN_SIZES = (W_A, W_A, W_A, W_BK, W_BK, W_BV, W_BV, GK_RANK, D_MODEL, D_MODEL)
D_IN = 3 * W_A + 2 * W_BK + 2 * W_BV + GK_RANK + 2 * D_MODEL

kernel_name = 'hybrid_chunkband_gla_convffn_step'


def rmsnorm(x, g):
    xf = x.astype(jnp.float32)
    r = lax.rsqrt(jnp.mean(xf * xf, axis=-1, keepdims=True) + EPS)
    return (xf * r).astype(x.dtype) * g


def adaln_modulation(c, w_ada, b_ada):
    m = jax.nn.silu(c) @ w_ada + b_ada
    return jnp.split(m[:, None, :], 6, axis=-1)


def rel_bias_lookup(rel_bias, rel):
    return rel_bias[:, jnp.clip(rel, -MAX_REL, MAX_REL) + MAX_REL]


def band_attention_prompt(q, k, v, rel_bias):
    b, t, h, d = q.shape
    nc = t // CHUNK
    nband = BAND_CHUNKS + 1
    qc = q.reshape(b, nc, CHUNK, h, d)
    pad_k = jnp.zeros((b, BAND_CHUNKS, CHUNK, h, d), k.dtype)
    pad_v = jnp.zeros((b, BAND_CHUNKS, CHUNK, h, d), v.dtype)
    kc = jnp.concatenate([pad_k, k.reshape(b, nc, CHUNK, h, d)], axis=1)
    vc = jnp.concatenate([pad_v, v.reshape(b, nc, CHUNK, h, d)], axis=1)
    idx = jnp.arange(nc)[:, None] + jnp.arange(nband)[None, :]
    kb = kc[:, idx].reshape(b, nc, nband * CHUNK, h, d)
    vb = vc[:, idx].reshape(b, nc, nband * CHUNK, h, d)
    valid = jnp.repeat(idx >= BAND_CHUNKS, CHUNK, axis=1)
    qi = jnp.arange(CHUNK)
    kr = jnp.arange(nband * CHUNK) - BAND_CHUNKS * CHUNK
    bias = rel_bias_lookup(rel_bias, qi[:, None] - kr[None, :]).astype(jnp.float32)
    s = jnp.einsum('bcqhd,bckhd->bchqk', qc, kb).astype(jnp.float32) * (d ** -0.5) + bias
    s = jnp.where(valid[None, :, None, None, :], s, NEG_INF)
    p = jax.nn.softmax(s, axis=-1).astype(v.dtype)
    o = jnp.einsum('bchqk,bckhd->bcqhd', p, vb)
    return o.reshape(b, t, h * d)


def band_attention_sample(q, k_new, v_new, k_cache, v_cache, rel_bias):
    b, s_len, h, d = q.shape
    w = k_cache.shape[1]
    kk = jnp.concatenate([k_cache, k_new], axis=1)
    vv = jnp.concatenate([v_cache, v_new], axis=1)
    qpos = PAST_LEN + jnp.arange(s_len)
    kpos = jnp.concatenate([PAST_LEN - w + jnp.arange(w), qpos])
    bias = rel_bias_lookup(rel_bias, qpos[:, None] - kpos[None, :]).astype(jnp.float32)
    s = jnp.einsum('bqhd,bkhd->bhqk', q, kk).astype(jnp.float32) * (d ** -0.5) + bias
    p = jax.nn.softmax(s, axis=-1).astype(vv.dtype)
    o = jnp.einsum('bhqk,bkhd->bqhd', p, vv)
    return o.reshape(b, s_len, h * d)


def gla(q, k, v, log_a, s0):
    b, t, h, dk = q.shape
    dv = v.shape[-1]
    pad = (-t) % GLA_BLOCK
    if pad:
        cfg = ((0, 0), (0, pad), (0, 0), (0, 0))
        q, k, v, log_a = (jnp.pad(a, cfg) for a in (q, k, v, log_a))
    nb = (t + pad) // GLA_BLOCK
    rs = lambda a: a.reshape(b, nb, GLA_BLOCK, h, a.shape[-1]).astype(jnp.float32)
    qb, kb, vb, ab = rs(q), rs(k), rs(v), rs(log_a)
    cum = jnp.cumsum(ab, axis=2)
    cum_end = cum[:, :, -1:]
    q_t = qb * jnp.exp(cum) * (dk ** -0.5)
    k_t = kb * jnp.exp(-cum)
    k_end = kb * jnp.exp(cum_end - cum)
    mask = jnp.tril(jnp.ones((GLA_BLOCK, GLA_BLOCK), jnp.float32))
    att = jnp.einsum('bnthk,bnshk->bnhts', q_t, k_t) * mask
    o_intra = jnp.einsum('bnhts,bnshv->bnthv', att, vb)
    upd = jnp.einsum('bnshk,bnshv->bnhkv', k_end, vb)
    dec = jnp.exp(cum_end[:, :, 0])

    def step(state, xs):
        u, dcy = xs
        return dcy[..., None] * state + u, state

    s_fin, s_prev = lax.scan(step, s0.astype(jnp.float32),
                             (jnp.swapaxes(upd, 0, 1), jnp.swapaxes(dec, 0, 1)))
    s_prev = jnp.swapaxes(s_prev, 0, 1)
    o_inter = jnp.einsum('bnthk,bnhkv->bnthv', q_t, s_prev)
    o = (o_intra + o_inter).reshape(b, nb * GLA_BLOCK, h, dv)[:, :t]
    return o.astype(v.dtype), s_fin.astype(s0.dtype)


def conv_ffn(h, conv_state, w_up, w_dw, b_dw, w_down):
    t = h.shape[1]
    u = h @ w_up
    uu = jnp.concatenate([conv_state.astype(u.dtype), u], axis=1)
    y = b_dw
    for j in range(CONV_W):
        y = y + w_dw[j] * uu[:, j:j + t]
    a, g = jnp.split(y, 2, axis=-1)
    out = (jax.nn.gelu(a, approximate=True) * g) @ w_down
    return out, uu[:, -(CONV_W - 1):]


def trunk_layer(x, c, k_cache, v_cache, s_gla, s_conv, p, first_chunk):
    b, t, _ = x.shape
    shift_m, scale_m, gate_m, shift_f, scale_f, gate_f = adaln_modulation(c, p['w_ada'], p['b_ada'])

    h = rmsnorm(x, p['g_pre_mix']) * (1.0 + scale_m) + shift_m
    z = h @ p['w_in']
    qa, ka, va, qb, kb, vb, gb, gk_low, gate_a, gate_b = jnp.split(
        z, np.cumsum(IN_SIZES)[:-1].tolist(), axis=-1)
    qa = qa.reshape(b, t, H_A, HD_A)
    ka = ka.reshape(b, t, H_A, HD_A)
    va = va.reshape(b, t, H_A, HD_A)
    if first_chunk:
        ya = band_attention_prompt(qa, ka, va, p['rel_bias'])
        rows = min(WINDOW_A, t)
        k_keep, v_keep = ka[:, t - rows:], va[:, t - rows:]
        s_gla = jnp.zeros((b, H_B, DK_B, DV_B), x.dtype)
        s_conv = jnp.zeros((b, CONV_W - 1, 2 * D_FF), x.dtype)
    else:
        ya = band_attention_sample(qa, ka, va, k_cache, v_cache, p['rel_bias'])
        k_keep, v_keep = ka, va
    log_a = jax.nn.log_sigmoid((gk_low @ p['w_gk2'] + p['b_gk']).astype(jnp.float32)) / GK_NORM
    yb, s_gla_new = gla(qb.reshape(b, t, H_B, DK_B), kb.reshape(b, t, H_B, DK_B),
                        vb.reshape(b, t, H_B, DV_B), log_a.reshape(b, t, H_B, DK_B), s_gla)
    yb = rmsnorm(yb, p['g_gla']) * jax.nn.silu(gb.reshape(b, t, H_B, DV_B))
    yb = yb.reshape(b, t, W_BV)
    merged = jax.nn.sigmoid(gate_a) * (ya @ p['w_br_a']) + jax.nn.sigmoid(gate_b) * (yb @ p['w_br_b'])
    x = x + gate_m * rmsnorm(merged @ p['w_out'], p['g_post_mix'])

    h = rmsnorm(x, p['g_pre_ffn']) * (1.0 + scale_f) + shift_f
    yf, conv_new = conv_ffn(h, s_conv, p['w_up'], p['w_dw'], p['b_dw'], p['w_down'])
    x = x + gate_f * rmsnorm(yf, p['g_post_ffn'])
    return x, k_keep, v_keep, s_gla_new, conv_new


def setup_inputs(seed: int = 0) -> dict:
    key = jax.random.key(seed)
    ks = jax.random.split(key, 26)
    kv_rows = min(WINDOW_A, PAST_LEN)

    def nrm(k, shape, scale):
        return jax.random.normal(k, shape, jnp.float32) * scale

    return {
        'x_prompt': nrm(ks[0], (BATCH, SEQ, D_MODEL), 1.0),
        'x_sample': nrm(ks[1], (DEC_BATCH, DEC_SEQ, D_MODEL), 1.0),
        'cache_k_a': nrm(ks[2], (DEPTH, DEC_BATCH, kv_rows, H_A, HD_A), 1.0),
        'cache_v_a': nrm(ks[3], (DEPTH, DEC_BATCH, kv_rows, H_A, HD_A), 1.0),
        'state_gla': nrm(ks[4], (DEPTH, DEC_BATCH, H_B, DK_B, DV_B), 1.0),
        'state_conv': nrm(ks[5], (DEPTH, DEC_BATCH, CONV_W - 1, 2 * D_FF), 1.0),
        'c_prompt': nrm(ks[6], (BATCH, D_MODEL), 1.0),
        'c_sample': nrm(ks[7], (DEC_BATCH, D_MODEL), 1.0),
        'w_ada': nrm(ks[8], (DEPTH, D_MODEL, 6 * D_MODEL), 0.5 * D_MODEL ** -0.5),
        'b_ada': nrm(ks[9], (DEPTH, 6 * D_MODEL), 0.01),
        'g_pre_mix': 1.0 + nrm(ks[10], (DEPTH, D_MODEL), 0.05),
        'g_post_mix': 1.0 + nrm(ks[11], (DEPTH, D_MODEL), 0.05),
        'g_pre_ffn': 1.0 + nrm(ks[12], (DEPTH, D_MODEL), 0.05),
        'g_post_ffn': 1.0 + nrm(ks[13], (DEPTH, D_MODEL), 0.05),
        'w_in': nrm(ks[14], (DEPTH, D_MODEL, D_IN), D_MODEL ** -0.5),
        'w_gk2': nrm(ks[15], (DEPTH, GK_RANK, W_BK), GK_RANK ** -0.5),
        'b_gk': nrm(ks[16], (DEPTH, W_BK), 0.1),
        'rel_bias': nrm(ks[17], (DEPTH, H_A, 2 * MAX_REL + 1), 0.5),
        'g_gla': 1.0 + nrm(ks[18], (DEPTH, DV_B), 0.05),
        'w_br_a': nrm(ks[19], (DEPTH, W_A, D_MODEL), W_A ** -0.5),
        'w_br_b': nrm(ks[20], (DEPTH, W_BV, D_MODEL), W_BV ** -0.5),
        'w_out': nrm(ks[21], (DEPTH, D_MODEL, D_MODEL), D_MODEL ** -0.5),
        'w_up': nrm(ks[22], (DEPTH, D_MODEL, 2 * D_FF), D_MODEL ** -0.5),
        'w_dw': nrm(ks[23], (DEPTH, CONV_W, 2 * D_FF), CONV_W ** -0.5),
        'b_dw': nrm(ks[24], (DEPTH, 2 * D_FF), 0.01),
        'w_down': nrm(ks[25], (DEPTH, D_FF, D_MODEL), D_FF ** -0.5),
    }


def reference(x_prompt, x_sample, cache_k_a, cache_v_a, state_gla, state_conv, c_prompt, c_sample,
              w_ada, b_ada, g_pre_mix, g_post_mix, g_pre_ffn, g_post_ffn, w_in, w_gk2, b_gk,
              rel_bias, g_gla, w_br_a, w_br_b, w_out, w_up, w_dw, b_dw, w_down):
    yp, ys = x_prompt, x_sample
    kp_l, vp_l, gp_l, cp_l, ks_l, vs_l, gs_l, cs_l = [], [], [], [], [], [], [], []
    for l in range(DEPTH):
        p = {'w_ada': w_ada[l], 'b_ada': b_ada[l], 'g_pre_mix': g_pre_mix[l],
             'g_post_mix': g_post_mix[l], 'g_pre_ffn': g_pre_ffn[l], 'g_post_ffn': g_post_ffn[l],
             'w_in': w_in[l], 'w_gk2': w_gk2[l], 'b_gk': b_gk[l], 'rel_bias': rel_bias[l],
             'g_gla': g_gla[l], 'w_br_a': w_br_a[l], 'w_br_b': w_br_b[l], 'w_out': w_out[l],
             'w_up': w_up[l], 'w_dw': w_dw[l], 'b_dw': b_dw[l], 'w_down': w_down[l]}
        yp, kp, vp, gp, cp = trunk_layer(yp, c_prompt, None, None, None, None, p, True)
        ys, kn, vn, gn, cn = trunk_layer(ys, c_sample, cache_k_a[l], cache_v_a[l],
                                         state_gla[l], state_conv[l], p, False)
        kp_l.append(kp); vp_l.append(vp); gp_l.append(gp); cp_l.append(cp)
        ks_l.append(kn); vs_l.append(vn); gs_l.append(gn); cs_l.append(cn)
    k_a_prompt = jnp.stack(kp_l)
    v_a_prompt = jnp.stack(vp_l)
    gla_prompt = jnp.stack(gp_l)
    conv_prompt = jnp.stack(cp_l)
    k_a_sample = jnp.stack(ks_l)
    v_a_sample = jnp.stack(vs_l)
    gla_sample = jnp.stack(gs_l)
    conv_sample = jnp.stack(cs_l)
    return (yp, ys, k_a_prompt, v_a_prompt, gla_prompt, conv_prompt,
            k_a_sample, v_a_sample, gla_sample, conv_sample)
```

```cpp
#include <hip/hip_runtime.h>
#include <cstdio>
#include <cstdint>

#define LAS __attribute__((address_space(3)))
#define GAS __attribute__((address_space(1)))
typedef unsigned short bf16_t;
typedef short bf16x8 __attribute__((ext_vector_type(8)));
typedef float f32x4 __attribute__((ext_vector_type(4)));
typedef float f32x2 __attribute__((ext_vector_type(2)));
typedef float f32x16 __attribute__((ext_vector_type(16)));
typedef unsigned u32x4 __attribute__((ext_vector_type(4)));
typedef unsigned u32x2 __attribute__((ext_vector_type(2)));

constexpr int DM = 1024, SEQ = 4096, NBP = 4, NBS = 32, SSEQ = 32;
constexpr int MP = NBP * SEQ, MS = NBS * SSEQ, M = MP + MS;
constexpr int LDZ = 5376;
constexpr int ZQ = 0, ZK = 512, ZV = 1024, ZQB = 1536, ZKB = 1792, ZVB = 2048, ZGB = 2560, ZGK = 3072, ZGA = 3328, ZGT = 4352;
constexpr int NUP = 5632, DFF = 2816, DIN = 5136;
constexpr float EPS = 1e-6f, LOG2E = 1.4426950408889634f;
constexpr float C2 = 0.125f * LOG2E;
constexpr size_t O_Y = 0, O_KP = 17825792, O_VP = 18874368, O_GP = 19922944, O_CP = 20054016, O_KS = 20099072, O_VS = 20623360, O_GS = 21147648, O_CS = 22196224, O_END = 22556672;

constexpr size_t MiB = 1u << 20;
constexpr size_t WS_CTL = 0, CTL_ZERO_BYTES = 2 * MiB;
constexpr size_t WS_MOD = 1 * MiB;
constexpr size_t WS_WIN = 2 * MiB;
constexpr size_t WS_WBR = WS_WIN + (size_t)LDZ * 1024 * 2;
constexpr size_t WS_WOUT = WS_WBR + 2 * MiB;
constexpr size_t WS_WUP = WS_WOUT + 2 * MiB;
constexpr size_t WS_WDN = WS_WUP + (size_t)NUP * 1024 * 2;
constexpr size_t WS_B = WS_WDN + (size_t)1024 * DFF * 2;
constexpr size_t WS_A = WS_B + (size_t)M * 1024 * 2;
constexpr size_t WS_END = WS_A + (size_t)M * NUP * 2;
constexpr size_t WS_HALO = WS_WIN;
constexpr size_t WS_D = WS_B + 33 * MiB;
static_assert(WS_END <= 256 * MiB, "workspace");
constexpr int CW_TMO = 0, CW_BAR = 4096;

constexpr int RING_BYTES = 131072, SCR_PER_WAVE = 18944, LDSCTL_OFF = 8 * SCR_PER_WAVE, MISC_OFF = LDSCTL_OFF + 320, LDS_BYTES = LDSCTL_OFF + 1024;
static_assert(LDSCTL_OFF >= RING_BYTES && LDS_BYTES <= 163840, "LDS map");
constexpr int NWAVES = 8;

__device__ __forceinline__ float bf2f(bf16_t b) { return __builtin_bit_cast(float, (unsigned)b << 16); }
__device__ __forceinline__ float bflo(unsigned w) { return __builtin_bit_cast(float, w << 16); }
__device__ __forceinline__ float bfhi(unsigned w) { return __builtin_bit_cast(float, w & 0xffff0000u); }
__device__ __forceinline__ unsigned cvt_pk_bf16(float lo, float hi) { unsigned r; asm volatile("v_cvt_pk_bf16_f32 %0, %1, %2" : "=v"(r) : "v"(lo), "v"(hi)); return r; }
__device__ __forceinline__ bf16_t f2bf(float f) { return (bf16_t)(cvt_pk_bf16(f, 0.f) & 0xffffu); }
__device__ __forceinline__ float fexp2(float x) { return __builtin_amdgcn_exp2f(x); }
__device__ __forceinline__ float frcp(float x) { return __builtin_amdgcn_rcpf(x); }
__device__ __forceinline__ float sigmoidf_(float x) { return frcp(1.0f + fexp2(-x * LOG2E)); }
__device__ __forceinline__ float wave_sum(float v) {
#pragma unroll
    for (int o = 1; o < 64; o <<= 1) v += __shfl_xor(v, o);
    return v;
}
__device__ __forceinline__ int crow(int r, int hi) { return (r & 3) + 8 * (r >> 2) + 4 * hi; }
__device__ __forceinline__ bf16x8 pack8(float a0, float a1, float a2, float a3, float a4, float a5, float a6, float a7) {
    u32x4 w; w.x = cvt_pk_bf16(a0, a1); w.y = cvt_pk_bf16(a2, a3); w.z = cvt_pk_bf16(a4, a5); w.w = cvt_pk_bf16(a6, a7);
    return __builtin_bit_cast(bf16x8, w);
}
#define LDS_WAIT() asm volatile("s_waitcnt lgkmcnt(0)" ::: "memory")
#define LAUNDER(x) asm volatile("" : "+v"(x))
#define VM_WAIT() asm volatile("s_waitcnt vmcnt(0)" ::: "memory")

namespace pg8 {
constexpr int BM = 256, BK = 64, HALF = 128, HTB = HALF * BK * 2, STAGE_BYTES = 8 * HTB, NXCD = 8, WGM = 8;
__host__ __device__ __forceinline__ int lds_byte(int r, int c) { const int st = (r >> 4) * 2 + (c >> 5), rr = r & 15, cc = c & 31, ob = rr * 64 + cc * 2; return st * 1024 + (ob ^ (((ob >> 9) & 1) << 5)); }
__host__ __device__ __forceinline__ void stage_rc(int b, int& R, int& C) { const int st = b / 1024, sb = b % 1024, swz = sb ^ (((sb >> 9) & 1) << 5); R = (st >> 1) * 16 + swz / 64; C = (st & 1) * 32 + (swz % 64) / 2; }
__host__ __device__ __forceinline__ int perm32(int rho) { const int n = rho >> 4, i = rho & 15; return 8 * (i >> 2) + 4 * n + (i & 3); }

struct Unit { int pm, pn; };
struct Gemm { const bf16_t* A; const bf16_t* Bt; int lda, ldb, K, ksplit; long ajump; };

struct StaticOrder {
    int nM, nN, nwg, G, c;
    __host__ __device__ void init(int M_, int N_, int G_, int c_) { nM = M_ / BM; nN = N_ / BM; nwg = nM * nN; G = G_; c = c_; }
    __host__ __device__ bool next(int i, Unit& u) const {
        const long L = (long)i * G + c; if (L >= nwg) return false;
        int wgid = (int)L; { const int q = nwg / NXCD, r = nwg % NXCD, xcd = wgid % NXCD, off = wgid / NXCD; wgid = (xcd < r ? xcd * (q + 1) : r * (q + 1) + (xcd - r) * q) + off; }
        const int nig = WGM * nN, gid = wgid / nig, fm = gid * WGM, gsz = (nM - fm) < WGM ? (nM - fm) : WGM;
        u.pm = fm + ((wgid % nig) % gsz); u.pn = (wgid % nig) / gsz; return true;
    }
};

struct EpiF32 {
    static constexpr bool PERM = false, HAS_MID = false;
    float* C; int ldc;
    __device__ __forceinline__ void mid(f32x4 (&)[2][2][4][2], const Unit&, int, int, int, int) const {}
    __device__ __forceinline__ void operator()(const f32x4 (&acc)[2][2][4][2], const Unit& u, int wr, int wc, int fr, int fq) const {
        const int row0 = u.pm * BM + wr * 64 + fr, col0 = u.pn * BM + wc * 32 + 4 * fq;
#pragma unroll
        for (int ai = 0; ai < 2; ++ai)
#pragma unroll
            for (int m = 0; m < 4; ++m) { float* rowp = C + (size_t)(row0 + ai * HALF + m * 16) * ldc + col0;
#pragma unroll
                for (int bj = 0; bj < 2; ++bj)
#pragma unroll
                    for (int n = 0; n < 2; ++n) *(f32x4*)(rowp + bj * HALF + n * 16) = acc[ai][bj][m][n]; }
    }
};

template <class Epi, class Sched, bool ALIGN_EPI>
__device__ __forceinline__ void gemm_phase(LAS unsigned char* lds, const Gemm g, const Sched& S, const Epi& E) {
    const int tid = threadIdx.x, wid = __builtin_amdgcn_readfirstlane(tid >> 6), lane = tid & 63, wr = wid >> 2, wc = wid & 3, fr = lane & 15, fq = lane >> 4;
    const int K = g.K, nt = K / BK;
    unsigned voffA[2], voffB[2];
#pragma unroll
    for (int i = 0; i < 2; ++i) { int R, C; stage_rc(tid * 16 + i * 8192, R, C); const int Rb = Epi::PERM ? ((R & ~31) + perm32(R & 31)) : R;
        voffA[i] = (unsigned)(R * g.lda + C) * 2u; voffB[i] = (unsigned)(Rb * g.ldb + C) * 2u; }
    const size_t kstep = (size_t)(BK * 2);
    const size_t hstepA = (size_t)HALF * g.lda * 2, hstepB = (size_t)HALF * g.ldb * 2, tstepA = 2 * hstepA, tstepB = 2 * hstepB;
    const unsigned ldsw = (unsigned)wid * 1024u;
    const int aoff = lds_byte(wr * 64 + fr, fq * 8), boff = lds_byte(wc * 32 + fr, fq * 8);
#define PG8_SA(b, h) (((b) * 2 + (h)) * HTB)
#define PG8_SB(b, h) ((4 + (b) * 2 + (h)) * HTB)
#define PG8_STAGE(bufoff, gbase, voff) do { _Pragma("unroll") for (int _i = 0; _i < 2; ++_i) \
        __builtin_amdgcn_global_load_lds((const unsigned*)((const char*)(gbase) + (voff)[_i]), (LAS unsigned*)(lds + (bufoff) + ldsw + _i * 8192), 16, 0, 0); } while (0)
#define PG8_LDA(dst, b, h) do { _Pragma("unroll") for (int m = 0; m < 4; ++m) _Pragma("unroll") for (int k = 0; k < 2; ++k) dst[m][k] = *(const LAS bf16x8*)(lds + PG8_SA(b, h) + aoff + m * 2048 + k * 1024); } while (0)
#define PG8_LDB(dst, b, h) do { _Pragma("unroll") for (int n = 0; n < 2; ++n) _Pragma("unroll") for (int k = 0; k < 2; ++k) dst[n][k] = *(const LAS bf16x8*)(lds + PG8_SB(b, h) + boff + n * 2048 + k * 1024); } while (0)
#define PG8_MMA(ai, bj, At, Bt) do { __builtin_amdgcn_s_setprio(1); _Pragma("unroll") for (int m = 0; m < 4; ++m) _Pragma("unroll") for (int n = 0; n < 2; ++n) _Pragma("unroll") for (int k = 0; k < 2; ++k) \
        acc[ai][bj][m][n] = __builtin_amdgcn_mfma_f32_16x16x32_bf16(Bt[n][k], At[m][k], acc[ai][bj][m][n], 0, 0, 0); __builtin_amdgcn_s_setprio(0); } while (0)
#define PG8_WAIT_V(n) asm volatile("s_waitcnt vmcnt(" #n ")" ::: "memory")
#define PG8_WAIT_L(n) asm volatile("s_waitcnt lgkmcnt(" #n ")" ::: "memory")
#define PG8_BAR __builtin_amdgcn_s_barrier()
#define PG8_SCHED __builtin_amdgcn_sched_barrier(0)
#define PG8_KOFF(t) ((size_t)(t) * kstep + ((t) >= g.ksplit ? (size_t)g.ajump : (size_t)0))
    Unit cur, nxt; int ui = 0;
    if (!S.next(0, cur)) return;
    f32x4 acc[2][2][4][2];
#pragma unroll
    for (int a = 0; a < 2; ++a)
#pragma unroll
        for (int b = 0; b < 2; ++b)
#pragma unroll
            for (int m = 0; m < 4; ++m)
#pragma unroll
                for (int n = 0; n < 2; ++n) acc[a][b][m][n] = (f32x4){0.f, 0.f, 0.f, 0.f};
    bf16x8 At[4][2], B0[2][2], B1[2][2];
    const char* cA = (const char*)g.A + (size_t)cur.pm * tstepA; const char* cB = (const char*)g.Bt + (size_t)cur.pn * tstepB;
    PG8_STAGE(PG8_SB(0, 0), cB, voffB); PG8_STAGE(PG8_SB(0, 1), cB + hstepB, voffB); PG8_STAGE(PG8_SA(0, 0), cA, voffA); PG8_STAGE(PG8_SA(0, 1), cA + hstepA, voffA);
    if (wr == 1) PG8_BAR;
    PG8_WAIT_V(2); PG8_BAR;
    PG8_STAGE(PG8_SB(1, 0), cB + kstep, voffB); PG8_STAGE(PG8_SA(1, 0), cA + kstep, voffA); PG8_STAGE(PG8_SB(1, 1), cB + hstepB + kstep, voffB);
    PG8_WAIT_V(6); PG8_BAR;
    for (;;) {
        const bool has_next = S.next(ui + 1, nxt);
        const char* nA = has_next ? (const char*)g.A + (size_t)nxt.pm * tstepA : cA; const char* nB = has_next ? (const char*)g.Bt + (size_t)nxt.pn * tstepB : cB;
        for (int tb = 0; tb < nt;) {
        const int te = (Epi::HAS_MID && tb < g.ksplit && g.ksplit < nt) ? g.ksplit : nt;
        if constexpr (Epi::HAS_MID) { if (tb == g.ksplit) { PG8_SCHED; E.mid(acc, cur, wr, wc, fr, fq); PG8_SCHED; } }
        for (int t = tb; t < te; t += 2) {
            const bool last = (t == nt - 2);
            const char* a1 = cA + PG8_KOFF(t) + kstep;
            const char* a2 = last ? nA : cA + PG8_KOFF(t + 2); const char* b2 = last ? nB : cB + (size_t)(t + 2) * kstep;
            const char* a3 = a2 + kstep; const char* b3 = b2 + kstep;
            PG8_LDB(B0, 0, 0); PG8_LDB(B1, 0, 1); PG8_SCHED; PG8_LDA(At, 0, 0); PG8_STAGE(PG8_SA(1, 1), a1 + hstepA, voffA);
            PG8_WAIT_V(8); PG8_WAIT_L(0); PG8_BAR; PG8_MMA(0, 0, At, B0); PG8_MMA(0, 1, At, B1); PG8_BAR; PG8_SCHED;
            PG8_LDA(At, 0, 1); PG8_STAGE(PG8_SB(0, 0), b2, voffB); PG8_STAGE(PG8_SB(0, 1), b2 + hstepB, voffB); PG8_STAGE(PG8_SA(0, 0), a2, voffA);
            PG8_WAIT_V(8); PG8_WAIT_L(0); PG8_BAR; PG8_MMA(1, 0, At, B0); PG8_MMA(1, 1, At, B1); PG8_BAR; PG8_SCHED;
            PG8_LDB(B0, 1, 0); PG8_LDB(B1, 1, 1); PG8_SCHED; PG8_LDA(At, 1, 0); PG8_STAGE(PG8_SA(0, 1), a2 + hstepA, voffA);
            PG8_WAIT_V(8); PG8_WAIT_L(0); PG8_BAR; PG8_MMA(0, 0, At, B0); PG8_MMA(0, 1, At, B1); PG8_BAR; PG8_SCHED;
            PG8_LDA(At, 1, 1); PG8_STAGE(PG8_SB(1, 0), b3, voffB); PG8_STAGE(PG8_SB(1, 1), b3 + hstepB, voffB); PG8_STAGE(PG8_SA(1, 0), a3, voffA);
            PG8_WAIT_V(8); PG8_WAIT_L(0); PG8_BAR; PG8_MMA(1, 0, At, B0); PG8_MMA(1, 1, At, B1); PG8_BAR; PG8_SCHED;
        }
        tb = te;
        }
        if constexpr (ALIGN_EPI) { if (wr == 0) PG8_BAR; }
        E(acc, cur, wr, wc, fr, fq);
        if (!has_next) break;
#pragma unroll
        for (int a = 0; a < 2; ++a)
#pragma unroll
            for (int b = 0; b < 2; ++b)
#pragma unroll
                for (int m = 0; m < 4; ++m)
#pragma unroll
                    for (int n = 0; n < 2; ++n) acc[a][b][m][n] = (f32x4){0.f, 0.f, 0.f, 0.f};
        cur = nxt; cA = nA; cB = nB; ++ui;
        if constexpr (ALIGN_EPI) { if (wr == 1) PG8_BAR; }
    }
    PG8_WAIT_V(0);
    if constexpr (!ALIGN_EPI) { if (wr == 0) PG8_BAR; }
    PG8_BAR;
#undef PG8_SA
#undef PG8_SB
#undef PG8_STAGE
#undef PG8_LDA
#undef PG8_LDB
#undef PG8_MMA
#undef PG8_WAIT_V
#undef PG8_WAIT_L
#undef PG8_BAR
#undef PG8_SCHED
#undef PG8_KOFF
}
}

struct EpiZ {
    static constexpr bool PERM = true, HAS_MID = false;
    bf16_t* Z; float* out;
    __device__ __forceinline__ void mid(f32x4 (&)[2][2][4][2], const pg8::Unit&, int, int, int, int) const {}
    __device__ __forceinline__ void operator()(const f32x4 (&acc)[2][2][4][2], const pg8::Unit& u, int wr, int wc, int fr, int fq) const {
        const int pn = u.pn, row0 = u.pm * 256 + wr * 64 + fr, col0 = pn * 256 + wc * 32 + 8 * fq;
        const int mode = (pn < 2) ? 1 : (pn == 10 || pn == 11) ? 2 : (pn >= 13) ? 3 : 0;
        const bool kv = (pn >= 2 && pn <= 5) && (u.pm >= 64 || (u.pm & 15) >= 14);
        float* kvbase = nullptr; int kcol0 = 0;
        if (kv) { kcol0 = (pn & 1) * 256 + wc * 32 + 8 * fq; const bool isv = pn >= 4;
            kvbase = out + (u.pm >= 64 ? (isv ? O_VS : O_KS) : (isv ? O_VP : O_KP)); }
#pragma unroll
        for (int ai = 0; ai < 2; ++ai)
#pragma unroll
            for (int m = 0; m < 4; ++m) { const int row = row0 + ai * 128 + m * 16; bf16_t* rowp = Z + (size_t)row * LDZ + col0;
                size_t kvrow = 0;
                if (kv) { if (u.pm >= 64) kvrow = (size_t)(row - MP) * 512; else { const int b = row >> 12, t = row & 4095; kvrow = (size_t)(b * 512 + (t - 3584)) * 512; } }
#pragma unroll
                for (int bj = 0; bj < 2; ++bj) { f32x4 v0 = acc[ai][bj][m][0], v1 = acc[ai][bj][m][1];
                    if (kv) { float* p = kvbase + kvrow + kcol0 + bj * 128; *(f32x4*)p = v0; *(f32x4*)(p + 4) = v1; }
                    if (mode == 1) { v0 = v0 * C2; v1 = v1 * C2; }
                    else if (mode == 2) {
#pragma unroll
                        for (int j = 0; j < 4; ++j) { v0[j] = v0[j] * sigmoidf_(v0[j]); v1[j] = v1[j] * sigmoidf_(v1[j]); } }
                    else if (mode == 3) {
#pragma unroll
                        for (int j = 0; j < 4; ++j) { v0[j] = sigmoidf_(v0[j]); v1[j] = sigmoidf_(v1[j]); } }
                    u32x4 w; w.x = cvt_pk_bf16(v0[0], v0[1]); w.y = cvt_pk_bf16(v0[2], v0[3]); w.z = cvt_pk_bf16(v1[0], v1[1]); w.w = cvt_pk_bf16(v1[2], v1[3]);
                    *(u32x4*)(rowp + bj * 128) = w; } }
    }
};
struct EpiMerge {
    static constexpr bool PERM = true, HAS_MID = true;
    const bf16_t* Z; bf16_t* O;
    __device__ __forceinline__ void mid(f32x4 (&acc)[2][2][4][2], const pg8::Unit& u, int wr, int wc, int fr, int fq) const {
        const char* zb = (const char*)Z;
        const unsigned o0 = (unsigned)((u.pm * 256 + wr * 64 + fr) * LDZ + u.pn * 256 + wc * 32 + 8 * fq) * 2u;
#pragma unroll
        for (int ai = 0; ai < 2; ++ai)
#pragma unroll
            for (int m = 0; m < 4; ++m)
#pragma unroll
                for (int bj = 0; bj < 2; ++bj) { unsigned ob = o0; LAUNDER(ob); const unsigned o = ob + (unsigned)((ai * 128 + m * 16) * LDZ + bj * 128) * 2u;
                    const u32x4 a = *(const u32x4*)(zb + o + ZGA * 2), b = *(const u32x4*)(zb + o + ZGT * 2);
                    f32x4& v0 = acc[ai][bj][m][0]; f32x4& v1 = acc[ai][bj][m][1];
                    v0[0] *= bflo(a.x) * frcp(bflo(b.x)); v0[1] *= bfhi(a.x) * frcp(bfhi(b.x)); v0[2] *= bflo(a.y) * frcp(bflo(b.y)); v0[3] *= bfhi(a.y) * frcp(bfhi(b.y));
                    v1[0] *= bflo(a.z) * frcp(bflo(b.z)); v1[1] *= bfhi(a.z) * frcp(bfhi(b.z)); v1[2] *= bflo(a.w) * frcp(bflo(b.w)); v1[3] *= bfhi(a.w) * frcp(bfhi(b.w));
                    asm volatile("" : "+v"(v0), "+v"(v1) :: "memory"); }
    }
    __device__ __forceinline__ void operator()(const f32x4 (&acc)[2][2][4][2], const pg8::Unit& u, int wr, int wc, int fr, int fq) const {
        const int row0 = u.pm * 256 + wr * 64 + fr, col0 = u.pn * 256 + wc * 32 + 8 * fq;
#pragma unroll
        for (int ai = 0; ai < 2; ++ai)
#pragma unroll
            for (int m = 0; m < 4; ++m) { const int row = row0 + ai * 128 + m * 16; const bf16_t* zp = Z + (size_t)row * LDZ + ZGT + col0; bf16_t* op = O + (size_t)row * 1024 + col0;
#pragma unroll
                for (int bj = 0; bj < 2; ++bj) { const u32x4 b = *(const u32x4*)(zp + bj * 128); const f32x4 v0 = acc[ai][bj][m][0], v1 = acc[ai][bj][m][1];
                    u32x4 w; w.x = cvt_pk_bf16(v0[0] * bflo(b.x), v0[1] * bfhi(b.x)); w.y = cvt_pk_bf16(v0[2] * bflo(b.y), v0[3] * bfhi(b.y));
                    w.z = cvt_pk_bf16(v1[0] * bflo(b.z), v1[1] * bfhi(b.z)); w.w = cvt_pk_bf16(v1[2] * bflo(b.w), v1[3] * bfhi(b.w));
                    *(u32x4*)(op + bj * 128) = w; }
                asm volatile("" ::: "memory"); }
    }
};
struct EpiU {
    static constexpr bool PERM = true, HAS_MID = false;
    bf16_t* U; bf16_t* halo; float* out;
    __device__ __forceinline__ void mid(f32x4 (&)[2][2][4][2], const pg8::Unit&, int, int, int, int) const {}
    __device__ __forceinline__ void operator()(const f32x4 (&acc)[2][2][4][2], const pg8::Unit& u, int wr, int wc, int fr, int fq) const {
        const int row0 = u.pm * 256 + wr * 64 + fr, col0 = u.pn * 256 + wc * 32 + 8 * fq;
#pragma unroll
        for (int ai = 0; ai < 2; ++ai)
#pragma unroll
            for (int m = 0; m < 4; ++m) { const int row = row0 + ai * 128 + m * 16; bf16_t* rowp = U + (size_t)row * NUP + col0;
                const bool is_halo = (row < MP) && ((row & 63) >= 62);
                float* cp = nullptr;
                if (row < MP) { const int t = row & 4095; if (t >= 4094) cp = out + O_CP + (size_t)((row >> 12) * 2 + (t - 4094)) * NUP + col0; }
                else { const int rs = row - MP, t = rs & 31; if (t >= 30) cp = out + O_CS + (size_t)((rs >> 5) * 2 + (t - 30)) * NUP + col0; }
#pragma unroll
                for (int bj = 0; bj < 2; ++bj) { const f32x4 v0 = acc[ai][bj][m][0], v1 = acc[ai][bj][m][1];
                    u32x4 w; w.x = cvt_pk_bf16(v0[0], v0[1]); w.y = cvt_pk_bf16(v0[2], v0[3]); w.z = cvt_pk_bf16(v1[0], v1[1]); w.w = cvt_pk_bf16(v1[2], v1[3]);
                    *(u32x4*)(rowp + bj * 128) = w;
                    if (is_halo) *(u32x4*)(halo + (size_t)((row >> 6) * 2 + (row & 1)) * NUP + col0 + bj * 128) = w;
                    if (cp) { *(f32x4*)(cp + bj * 128) = v0; *(f32x4*)(cp + bj * 128 + 4) = v1; } } }
    }
};

#define XB_TMO      128
#define XB_XCNT(j)  (256  + 64 * (j))
#define XB_XSUB(j)  (1280 + 64 * (j))
#define XB_XGEN(j)  (2304 + 64 * (j))
#define XB_TOP      3328
#define XB_TOPGEN   3392
#define XCD_BAR_WORDS 3456
#define XB_SPIN_CAP (1u << 18)
__device__ __forceinline__ unsigned xb_ld(unsigned* p)              { return __hip_atomic_load(p, __ATOMIC_RELAXED, __HIP_MEMORY_SCOPE_AGENT); }
__device__ __forceinline__ unsigned xb_add(unsigned* p, unsigned v) { return __hip_atomic_fetch_add(p, v, __ATOMIC_RELAXED, __HIP_MEMORY_SCOPE_AGENT); }
__device__ __forceinline__ unsigned xb_xcc_id() { return (unsigned)__builtin_amdgcn_s_getreg((3 << 11) | 20) & 0xFu; }
#define XB_SPIN(cond, bar) do { unsigned _sp = 0; while (cond) { __builtin_amdgcn_s_sleep(1); \
    if ((++_sp & 255u) == 0u) { if (xb_ld(&(bar)[XB_TMO])) break; if (_sp > XB_SPIN_CAP) { atomicAdd(&(bar)[XB_TMO], 1u); break; } } } } while (0)
struct XcdBarrier { unsigned* bar; unsigned x; volatile LAS unsigned* st; };
__device__ __forceinline__ XcdBarrier xcd_barrier_post(unsigned* bar, volatile LAS unsigned* st) {
    XcdBarrier b; b.bar = bar; b.x = xb_xcc_id(); b.st = st;
    if (threadIdx.x == 0) (void)xb_add(&bar[XB_XCNT(b.x)], 1u);
    return b;
}
__device__ __forceinline__ void xcd_barrier_complete(unsigned* bar, unsigned x, unsigned& nloc, unsigned& nx) {
    const unsigned G = gridDim.x * gridDim.y * gridDim.z;
    unsigned sum, cnt, mine, sp = 0u;
    for (;;) {
        sum = 0u; cnt = 0u; mine = 0u;
#pragma unroll
        for (unsigned j = 0; j < 16; ++j) { const unsigned c = xb_ld(&bar[XB_XCNT(j)]); sum += c; cnt += (c > 0u) ? 1u : 0u; mine = (j == x) ? c : mine; }
        if (sum == G) break;
        __builtin_amdgcn_s_sleep(1);
        if ((++sp & 255u) == 0u) { if (xb_ld(&bar[XB_TMO])) break; if (sp > XB_SPIN_CAP) { atomicAdd(&bar[XB_TMO], 1u); break; } }
    }
    nloc = mine > 0u ? mine : 1u; nx = cnt > 0u ? cnt : 1u;
}
__device__ __forceinline__ void xcd_barrier(const XcdBarrier& b) {
    asm volatile("s_waitcnt vmcnt(0)" ::: "memory");
    __syncthreads();
    if (threadIdx.x == 0) {
        unsigned* bar = b.bar;
        __builtin_amdgcn_s_waitcnt(0);
        unsigned nloc = b.st[0], nx = b.st[1];
        if (nloc == 0u) { xcd_barrier_complete(bar, b.x, nloc, nx); b.st[0] = nloc; b.st[1] = nx; }
        const unsigned old = xb_add(&bar[XB_XSUB(b.x)], 1u);
        const unsigned gen = old / nloc;
        if (old + 1u == (gen + 1u) * nloc) {
            __builtin_amdgcn_fence(__ATOMIC_RELEASE, "agent");
            asm volatile("s_waitcnt vmcnt(0)" ::: "memory");
            const unsigned og = xb_add(&bar[XB_TOP], 1u);
            const unsigned tg = og / nx;
            if (og + 1u == (tg + 1u) * nx) xb_add(&bar[XB_TOPGEN], 1u);
            else XB_SPIN(xb_ld(&bar[XB_TOPGEN]) == tg, bar);
            __builtin_amdgcn_fence(__ATOMIC_ACQUIRE, "agent");
            xb_add(&bar[XB_XGEN(b.x)], 1u);
            asm volatile("s_waitcnt vmcnt(0)" ::: "memory");
        } else {
            XB_SPIN(xb_ld(&bar[XB_XGEN(b.x)]) == gen, bar);
            __builtin_amdgcn_fence(__ATOMIC_ACQUIRE, "agent");
            asm volatile("s_waitcnt vmcnt(0)" ::: "memory");
        }
    }
    __syncthreads();
}

struct Args { const float* in[26]; float* out; unsigned char* ws; int ph_lo, ph_hi; };
enum { I_XP = 0, I_XS, I_CK, I_CV, I_SG, I_SC, I_CP, I_CS, I_WADA, I_BADA, I_GPM, I_GQM, I_GPF, I_GQF, I_WIN, I_WGK2, I_BGK, I_RELB, I_GGLA, I_WBRA, I_WBRB, I_WOUT, I_WUP, I_WDW, I_BDW, I_WDN };
struct Frame {
    LAS unsigned char* lds;
    int tid, lane, wave, vcu, G;
    float* out; unsigned char* ws;
};
#define FW(T, off) ((T*)(F.ws + (off)))
#define F_mod FW(float, WS_MOD)
#define F_Win FW(bf16_t, WS_WIN)
#define F_Wbr FW(bf16_t, WS_WBR)
#define F_Wout FW(bf16_t, WS_WOUT)
#define F_Wup FW(bf16_t, WS_WUP)
#define F_Wdn FW(bf16_t, WS_WDN)
#define F_XB FW(bf16_t, WS_B)
#define F_Z FW(bf16_t, WS_A)
#define F_halo FW(bf16_t, WS_HALO)
#define F_Ubuf FW(float, WS_B)
#define F_Dbuf FW(float, WS_D)
__device__ __forceinline__ const float* xrow(const Args& args, int row) { return row < MP ? args.in[I_XP] + (size_t)row * DM : args.in[I_XS] + (size_t)(row - MP) * DM; }
__device__ __forceinline__ int modrow(int row) { return row < MP ? (row >> 12) : NBP + ((row - MP) >> 5); }

__device__ __forceinline__ void p0_transpose_item(const float* W, int ldw, int nblk, bf16_t* WT, int ldt, LAS float* scr, int item, int lane) {
    const int kb = item / nblk, nb = item % nblk, k0 = 64 * kb, n0 = 32 * nb;
#pragma unroll 8
    for (int i = 0; i < 32; ++i) { const int kk = 2 * i + (lane >> 5); scr[kk * 33 + (lane & 31)] = W[(size_t)(k0 + kk) * ldw + n0 + (lane & 31)]; }
    LDS_WAIT(); asm volatile("" ::: "memory");
    const int c = lane & 7;
#pragma unroll
    for (int j = 0; j < 4; ++j) { const int n = (lane >> 3) + 8 * j; const LAS float* s = scr + (8 * c) * 33 + n;
        u32x4 o; o.x = cvt_pk_bf16(s[0 * 33], s[1 * 33]); o.y = cvt_pk_bf16(s[2 * 33], s[3 * 33]); o.z = cvt_pk_bf16(s[4 * 33], s[5 * 33]); o.w = cvt_pk_bf16(s[6 * 33], s[7 * 33]);
        *(GAS u32x4*)(WT + (size_t)(n0 + n) * ldt + k0 + 8 * c) = o; }
    LDS_WAIT(); asm volatile("" ::: "memory");
}
__device__ __forceinline__ void p0_fold_item(const Args& args, const Frame& F, LAS float* scr, int item, int lane) {
    const int kb = item / 8, nb = item % 8, k0 = 64 * kb, n0 = 32 * nb;
    float wg[16];
#pragma unroll
    for (int r = 0; r < 16; ++r) wg[r] = args.in[I_WGK2][r * 256 + n0 + (lane & 31)];
#pragma unroll 4
    for (int i = 0; i < 32; ++i) { const int kk = 2 * i + (lane >> 5); const f32x4* wr_ = (const f32x4*)(args.in[I_WIN] + (size_t)(k0 + kk) * DIN + 3072);
        float s = 0.f;
#pragma unroll
        for (int q = 0; q < 4; ++q) { const f32x4 v = wr_[q]; s += v[0] * wg[4 * q] + v[1] * wg[4 * q + 1] + v[2] * wg[4 * q + 2] + v[3] * wg[4 * q + 3]; }
        scr[kk * 33 + (lane & 31)] = s; }
    LDS_WAIT(); asm volatile("" ::: "memory");
    const int c = lane & 7;
#pragma unroll
    for (int j = 0; j < 4; ++j) { const int n = (lane >> 3) + 8 * j; const LAS float* s = scr + (8 * c) * 33 + n;
        u32x4 o; o.x = cvt_pk_bf16(s[0 * 33], s[1 * 33]); o.y = cvt_pk_bf16(s[2 * 33], s[3 * 33]); o.z = cvt_pk_bf16(s[4 * 33], s[5 * 33]); o.w = cvt_pk_bf16(s[6 * 33], s[7 * 33]);
        *(GAS u32x4*)(F_Win + (size_t)(ZGK + n0 + n) * 1024 + k0 + 8 * c) = o; }
    LDS_WAIT(); asm volatile("" ::: "memory");
}
__device__ __forceinline__ void p0_ada_item(const Args& args, const Frame& F, int item, int lane) {
    const int g = item % 96, kc = item / 96, j = 64 * g + lane, k0 = 64 * kc;
    float w[64];
#pragma unroll
    for (int kk = 0; kk < 64; ++kk) w[kk] = args.in[I_WADA][(size_t)(k0 + kk) * 6144 + j];
    const float bias = (kc == 0) ? args.in[I_BADA][j] : 0.f;
    for (int b = 0; b < NBP + NBS; ++b) {
        const float cvv = (b < NBP) ? args.in[I_CP][b * DM + k0 + lane] : args.in[I_CS][(b - NBP) * DM + k0 + lane];
        const float s = cvv * sigmoidf_(cvv);
        float a = bias;
#pragma unroll
        for (int kk = 0; kk < 64; ++kk) a += __builtin_bit_cast(float, __builtin_amdgcn_readlane(__builtin_bit_cast(int, s), kk)) * w[kk];
        atomicAdd(F_mod + (size_t)b * 6144 + j, a);
    }
}
__device__ __forceinline__ void p0_prologue(const Args& args, Frame& F) {
    LAS float* scr = (LAS float*)(F.lds + F.wave * SCR_PER_WAVE);
    const int gw = F.vcu * NWAVES + F.wave, NGW = F.G * NWAVES;
    constexpr int I_ADA = 96 * 16, I_IN1 = 16 * 96, I_IN2 = 16 * 64, I_FOLD = 16 * 8, I_BRA = 8 * 32, I_BRB = 8 * 32, I_OUT = 16 * 32, I_UP = 16 * 176, I_DN = 44 * 32;
    constexpr int NITEMS = I_ADA + I_IN1 + I_IN2 + I_FOLD + I_BRA + I_BRB + I_OUT + I_UP + I_DN;
    for (int it = gw; it < NITEMS; it += NGW) {
        int r = it;
        if (r < I_ADA) { p0_ada_item(args, F, r, F.lane); continue; } r -= I_ADA;
        if (r < I_IN1) { p0_transpose_item(args.in[I_WIN], DIN, 96, F_Win, 1024, scr, r, F.lane); continue; } r -= I_IN1;
        if (r < I_IN2) { p0_transpose_item(args.in[I_WIN] + 3088, DIN, 64, F_Win + (size_t)ZGA * 1024, 1024, scr, r, F.lane); continue; } r -= I_IN2;
        if (r < I_FOLD) { p0_fold_item(args, F, scr, r, F.lane); continue; } r -= I_FOLD;
        if (r < I_BRA) { p0_transpose_item(args.in[I_WBRA], 1024, 32, F_Wbr, 1024, scr, r, F.lane); continue; } r -= I_BRA;
        if (r < I_BRB) { p0_transpose_item(args.in[I_WBRB], 1024, 32, F_Wbr + 512, 1024, scr, r, F.lane); continue; } r -= I_BRB;
        if (r < I_OUT) { p0_transpose_item(args.in[I_WOUT], 1024, 32, F_Wout, 1024, scr, r, F.lane); continue; } r -= I_OUT;
        if (r < I_UP) { p0_transpose_item(args.in[I_WUP], NUP, 176, F_Wup, 1024, scr, r, F.lane); continue; } r -= I_UP;
        p0_transpose_item(args.in[I_WDN], 1024, 32, F_Wdn, DFF, scr, r, F.lane);
    }
}

__device__ __forceinline__ void p1_rows(const Args& args, Frame& F) {
    const int gw = F.vcu * NWAVES + F.wave, NGW = F.G * NWAVES;
    for (int row = gw; row < M; row += NGW) {
        const f32x4* xr = (const f32x4*)xrow(args, row) + F.lane;
        const float* md = F_mod + (size_t)modrow(row) * 6144;
        f32x4 v[4]; float ss = 0.f;
#pragma unroll
        for (int j = 0; j < 4; ++j) { v[j] = xr[64 * j]; ss += (v[j].x * v[j].x + v[j].y * v[j].y) + (v[j].z * v[j].z + v[j].w * v[j].w); }
        const float r = 1.0f / sqrtf(wave_sum(ss) * (1.f / DM) + EPS);
        unsigned long long* o8 = (unsigned long long*)(F_XB + (size_t)row * DM) + F.lane;
#pragma unroll
        for (int j = 0; j < 4; ++j) { const int c = 4 * F.lane + 256 * j;
            const f32x4 g = *(const f32x4*)(args.in[I_GPM] + c), sc = *(const f32x4*)(md + 1024 + c), sh = *(const f32x4*)(md + c);
            const f32x4 h = (v[j] * r) * g * (sc + 1.0f) + sh;
            o8[64 * j] = (unsigned long long)cvt_pk_bf16(h.x, h.y) | ((unsigned long long)cvt_pk_bf16(h.z, h.w) << 32); }
    }
}
__device__ __forceinline__ void p8_rows(const Args& args, Frame& F) {
    const int gw = F.vcu * NWAVES + F.wave, NGW = F.G * NWAVES;
    for (int row = gw; row < M; row += NGW) {
        const f32x4* xr = (const f32x4*)xrow(args, row) + F.lane;
        f32x4* yr = (f32x4*)(F.out + O_Y + (size_t)row * DM) + F.lane;
        const float* md = F_mod + (size_t)modrow(row) * 6144;
        f32x4 v[4]; float ss = 0.f;
#pragma unroll
        for (int j = 0; j < 4; ++j) { v[j] = yr[64 * j]; ss += (v[j].x * v[j].x + v[j].y * v[j].y) + (v[j].z * v[j].z + v[j].w * v[j].w); }
        const float r = 1.0f / sqrtf(wave_sum(ss) * (1.f / DM) + EPS);
        float s2 = 0.f;
#pragma unroll
        for (int j = 0; j < 4; ++j) { const int c = 4 * F.lane + 256 * j;
            const f32x4 g = *(const f32x4*)(args.in[I_GQM] + c), gt = *(const f32x4*)(md + 2048 + c), x = xr[64 * j];
            v[j] = x + gt * ((v[j] * r) * g); yr[64 * j] = v[j];
            s2 += (v[j].x * v[j].x + v[j].y * v[j].y) + (v[j].z * v[j].z + v[j].w * v[j].w); }
        const float r2 = 1.0f / sqrtf(wave_sum(s2) * (1.f / DM) + EPS);
        unsigned long long* o8 = (unsigned long long*)(F_XB + (size_t)row * DM) + F.lane;
#pragma unroll
        for (int j = 0; j < 4; ++j) { const int c = 4 * F.lane + 256 * j;
            const f32x4 g = *(const f32x4*)(args.in[I_GPF] + c), sc = *(const f32x4*)(md + 4096 + c), sh = *(const f32x4*)(md + 3072 + c);
            const f32x4 h = (v[j] * r2) * g * (sc + 1.0f) + sh;
            o8[64 * j] = (unsigned long long)cvt_pk_bf16(h.x, h.y) | ((unsigned long long)cvt_pk_bf16(h.z, h.w) << 32); }
    }
}
__device__ __forceinline__ void p12_rows(const Args& args, Frame& F) {
    const int gw = F.vcu * NWAVES + F.wave, NGW = F.G * NWAVES;
    for (int row = gw; row < M; row += NGW) {
        const f32x4* fr_ = (const f32x4*)((const float*)(F.ws + WS_A) + (size_t)row * DFF + 1408) + F.lane;
        f32x4* yr = (f32x4*)(F.out + O_Y + (size_t)row * DM) + F.lane;
        const float* md = F_mod + (size_t)modrow(row) * 6144;
        f32x4 v[4]; float ss = 0.f;
#pragma unroll
        for (int j = 0; j < 4; ++j) { v[j] = fr_[64 * j]; ss += (v[j].x * v[j].x + v[j].y * v[j].y) + (v[j].z * v[j].z + v[j].w * v[j].w); }
        const float r = 1.0f / sqrtf(wave_sum(ss) * (1.f / DM) + EPS);
#pragma unroll
        for (int j = 0; j < 4; ++j) { const int c = 4 * F.lane + 256 * j;
            const f32x4 g = *(const f32x4*)(args.in[I_GQF] + c), gt = *(const f32x4*)(md + 5120 + c);
            yr[64 * j] = yr[64 * j] + gt * ((v[j] * r) * g); }
    }
}

struct AttnState { float m, l; f32x16 o0, o1; };
__device__ __forceinline__ float pl_max(float m) { auto rr = __builtin_amdgcn_permlane32_swap(__float_as_uint(m), __float_as_uint(m), false, false); return fmaxf(__uint_as_float(rr[0]), __uint_as_float(rr[1])); }
__device__ __forceinline__ float pl_sum(float m) { auto rr = __builtin_amdgcn_permlane32_swap(__float_as_uint(m), __float_as_uint(m), false, false); return __uint_as_float(rr[0]) + __uint_as_float(rr[1]); }
template <int SRC, int NKH>
__device__ __forceinline__ void attn_tile(AttnState& st, const bf16x8 (&qr)[4], const void* kb, const void* vb, int pitch, int off, int iq, LAS float* scr, int r, int hi) {
    f32x16 p[NKH];
#pragma unroll
    for (int kh = 0; kh < NKH; ++kh) {
        p[kh] = f32x16{};
#pragma unroll
        for (int ks = 0; ks < 4; ++ks) {
            bf16x8 kf;
            unsigned kl = (unsigned)(r * pitch + 8 * hi); LAUNDER(kl);
            if (SRC == 0) kf = *(const bf16x8*)((const bf16_t*)kb + (kl + (unsigned)(32 * kh * pitch + 16 * ks)));
            else { const f32x4* pp = (const f32x4*)((const float*)kb + (kl + (unsigned)(32 * kh * pitch + 16 * ks))); const f32x4 a = pp[0], b = pp[1]; kf = pack8(a[0], a[1], a[2], a[3], b[0], b[1], b[2], b[3]); }
            p[kh] = __builtin_amdgcn_mfma_f32_32x32x16_bf16(kf, qr[ks], p[kh], 0, 0, 0);
        }
    }
    if (off >= 191) { const float bc = scr[256];
#pragma unroll
        for (int kh = 0; kh < NKH; ++kh)
#pragma unroll
            for (int g = 0; g < 16; ++g) p[kh][g] += bc;
    } else {
#pragma unroll
        for (int kh = 0; kh < NKH; ++kh)
#pragma unroll
            for (int g = 0; g < 16; ++g) { int rel = iq - (32 * kh + crow(g, hi)) + off; rel = rel < -128 ? -128 : (rel > 128 ? 128 : rel); p[kh][g] += scr[rel + 128]; }
    }
    float mx = p[0][0];
#pragma unroll
    for (int kh = 0; kh < NKH; ++kh)
#pragma unroll
        for (int g = 0; g < 16; ++g) mx = fmaxf(mx, p[kh][g]);
    mx = pl_max(mx);
    const float mn = fmaxf(st.m, mx), alpha = fexp2(st.m - mn);
    float ps = 0.f;
#pragma unroll
    for (int kh = 0; kh < NKH; ++kh)
#pragma unroll
        for (int g = 0; g < 16; ++g) { p[kh][g] = fexp2(p[kh][g] - mn); ps += p[kh][g]; }
    st.l = st.l * alpha + ps; st.m = mn;
    if (hi == 0) scr[272 + r] = alpha;
    LDS_WAIT(); asm volatile("" ::: "memory");
#pragma unroll
    for (int g = 0; g < 16; ++g) { const float a = scr[272 + crow(g, hi)]; st.o0[g] *= a; st.o1[g] *= a; }
#pragma unroll
    for (int kh = 0; kh < NKH; ++kh)
#pragma unroll
        for (int s2 = 0; s2 < 2; ++s2) {
            const bf16x8 pa = pack8(p[kh][8 * s2], p[kh][8 * s2 + 1], p[kh][8 * s2 + 2], p[kh][8 * s2 + 3], p[kh][8 * s2 + 4], p[kh][8 * s2 + 5], p[kh][8 * s2 + 6], p[kh][8 * s2 + 7]);
#pragma unroll
            for (int nt = 0; nt < 2; ++nt) {
                float vv[8]; unsigned lb = (unsigned)(4 * hi * pitch + r); LAUNDER(lb);
#pragma unroll
                for (int j = 0; j < 8; ++j) { const unsigned idx = lb + (unsigned)((32 * kh + 16 * s2 + 8 * (j >> 2) + (j & 3)) * pitch + 32 * nt);
                    if (SRC == 0) vv[j] = bf2f(((const bf16_t*)vb)[idx]); else vv[j] = ((const float*)vb)[idx]; }
                const bf16x8 vf = pack8(vv[0], vv[1], vv[2], vv[3], vv[4], vv[5], vv[6], vv[7]);
                if (nt == 0) st.o0 = __builtin_amdgcn_mfma_f32_32x32x16_bf16(pa, vf, st.o0, 0, 0, 0); else st.o1 = __builtin_amdgcn_mfma_f32_32x32x16_bf16(pa, vf, st.o1, 0, 0, 0);
                asm volatile("" ::: "memory");
            }
        }
    LDS_WAIT(); asm volatile("" ::: "memory");
}
__device__ __forceinline__ void attn_item(const Args& args, Frame& F, int item, LAS float* scr) {
    const int lane = F.lane, r = lane & 31, hi = lane >> 5;
    int b, c = 0, h, qh = 0; bool sample = item >= 4096;
    if (!sample) { qh = item & 1; h = (item >> 1) & 7; c = (item >> 4) & 63; b = item >> 10; } else { const int s = item - 4096; h = s & 7; b = s >> 3; }
    for (int i = lane; i < 257; i += 64) scr[i] = args.in[I_RELB][h * 257 + i] * LOG2E;
    const int rowq0 = sample ? MP + 32 * b : b * SEQ + 64 * c + 32 * qh;
    bf16x8 qr[4];
#pragma unroll
    for (int ks = 0; ks < 4; ++ks) qr[ks] = *(const bf16x8*)(F_Z + (size_t)(rowq0 + r) * LDZ + ZQ + 64 * h + 16 * ks + 8 * hi);
    AttnState st; st.m = -1e30f; st.l = 0.f; st.o0 = f32x16{}; st.o1 = f32x16{};
    const int iq = 32 * qh + r;
    LDS_WAIT(); asm volatile("" ::: "memory");
    if (!sample) {
        for (int jb = (c >= 8 ? 0 : 8 - c); jb <= 8; ++jb) { const size_t key0 = (size_t)b * SEQ + 64 * (c - 8 + jb);
            attn_tile<0, 2>(st, qr, F_Z + key0 * LDZ + ZK + 64 * h, F_Z + key0 * LDZ + ZV + 64 * h, LDZ, (8 - jb) * 64, iq, scr, r, hi); }
    } else {
        for (int jt = 0; jt < 8; ++jt) { const size_t e0 = ((size_t)(b * 512 + 64 * jt) * 8 + h) * 64;
            attn_tile<1, 2>(st, qr, args.in[I_CK] + e0, args.in[I_CV] + e0, 512, 512 - 64 * jt, iq, scr, r, hi); }
        const size_t key0 = (size_t)MP + 32 * b;
        attn_tile<0, 1>(st, qr, F_Z + key0 * LDZ + ZK + 64 * h, F_Z + key0 * LDZ + ZV + 64 * h, LDZ, 0, iq, scr, r, hi);
    }
    const float lt = pl_sum(st.l);
    if (hi == 0) scr[304 + r] = lt;
    LDS_WAIT(); asm volatile("" ::: "memory");
#pragma unroll
    for (int g = 0; g < 16; ++g) { const int q = crow(g, hi); const float inv = frcp(scr[304 + q]);
        unsigned lb = (unsigned)(4 * hi * LDZ + r); if ((g & 3) == 0) LAUNDER(lb);
        bf16_t* op = F_Z + (size_t)rowq0 * LDZ + (lb + (unsigned)(((g & 3) + 8 * (g >> 2)) * LDZ + ZQ + 64 * h));
        op[0] = f2bf(st.o0[g] * inv); op[32] = f2bf(st.o1[g] * inv); }
    LDS_WAIT(); asm volatile("" ::: "memory");
}

__device__ __forceinline__ float logsig16(float x) {
    const float ax = fabsf(x); return (fminf(x, 0.f) - __logf(1.0f + __expf(-ax))) * 0.0625f;
}
template <int NTOK>
__device__ __forceinline__ void gla_local_item(const Args& args, Frame& F, int row0, int h, float* Uout, float* Dout, const float* S0, float* Sfin, LAS float* scr) {
    const int lane = F.lane, r = lane & 31, hi = lane >> 5;
    const bf16_t* zr = F_Z + (size_t)row0 * LDZ;
    const float bg = args.in[I_BGK][64 * h + lane];
    float Gt[NTOK]; float G = 0.f;
#pragma unroll
    for (int t = 0; t < NTOK; ++t) { unsigned lb = (unsigned)lane; if ((t & 7) == 0) LAUNDER(lb); const float x = bf2f(zr[lb + (unsigned)(t * LDZ + ZGK + 64 * h)]) + bg; G += logsig16(x); Gt[t] = G; }
    const float Gl = G, Dv = __expf(Gl);
    if (Dout) Dout[lane] = Dv;
    if (Sfin) { scr[lane] = Dv; }
#pragma unroll
    for (int t = 0; t < NTOK; ++t) { unsigned lb = (unsigned)lane; if ((t & 7) == 0) LAUNDER(lb); const float k = bf2f(zr[lb + (unsigned)(t * LDZ + ZKB + 64 * h)]); Gt[t] = k * __expf(Gl - Gt[t]); }
    bf16x8 F0[NTOK / 16], F1[NTOK / 16];
#pragma unroll
    for (int ks = 0; ks < NTOK / 16; ++ks) {
        u32x4 Y, X;
        Y.x = cvt_pk_bf16(Gt[16 * ks + 0], Gt[16 * ks + 1]); Y.y = cvt_pk_bf16(Gt[16 * ks + 2], Gt[16 * ks + 3]); Y.z = cvt_pk_bf16(Gt[16 * ks + 4], Gt[16 * ks + 5]); Y.w = cvt_pk_bf16(Gt[16 * ks + 6], Gt[16 * ks + 7]);
        X.x = cvt_pk_bf16(Gt[16 * ks + 8], Gt[16 * ks + 9]); X.y = cvt_pk_bf16(Gt[16 * ks + 10], Gt[16 * ks + 11]); X.z = cvt_pk_bf16(Gt[16 * ks + 12], Gt[16 * ks + 13]); X.w = cvt_pk_bf16(Gt[16 * ks + 14], Gt[16 * ks + 15]);
        u32x4 A0, A1;
        { auto s = __builtin_amdgcn_permlane32_swap(Y.x, X.x, false, false); A0.x = s[0]; A1.x = s[1]; }
        { auto s = __builtin_amdgcn_permlane32_swap(Y.y, X.y, false, false); A0.y = s[0]; A1.y = s[1]; }
        { auto s = __builtin_amdgcn_permlane32_swap(Y.z, X.z, false, false); A0.z = s[0]; A1.z = s[1]; }
        { auto s = __builtin_amdgcn_permlane32_swap(Y.w, X.w, false, false); A0.w = s[0]; A1.w = s[1]; }
        F0[ks] = __builtin_bit_cast(bf16x8, A0); F1[ks] = __builtin_bit_cast(bf16x8, A1);
    }
    LDS_WAIT(); asm volatile("" ::: "memory");
#pragma unroll 1
    for (int nt = 0; nt < 4; ++nt) {
        f32x16 a0 = f32x16{}, a1 = f32x16{};
#pragma unroll
        for (int ks = 0; ks < NTOK / 16; ++ks) {
            float vv[8]; unsigned lb = (unsigned)(8 * hi * LDZ + r); LAUNDER(lb);
#pragma unroll
            for (int j = 0; j < 8; ++j) vv[j] = bf2f(zr[lb + (unsigned)((16 * ks + j) * LDZ + ZVB + 128 * h + 32 * nt)]);
            const bf16x8 vf = pack8(vv[0], vv[1], vv[2], vv[3], vv[4], vv[5], vv[6], vv[7]);
            a0 = __builtin_amdgcn_mfma_f32_32x32x16_bf16(F0[ks], vf, a0, 0, 0, 0);
            a1 = __builtin_amdgcn_mfma_f32_32x32x16_bf16(F1[ks], vf, a1, 0, 0, 0);
            asm volatile("" ::: "memory");
        }
#pragma unroll
        for (int g = 0; g < 16; ++g) { const int ch = crow(g, hi); unsigned lb = (unsigned)(4 * hi * 128 + r); if ((g & 3) == 0) LAUNDER(lb); const unsigned i0 = lb + (unsigned)(((g & 3) + 8 * (g >> 2)) * 128 + 32 * nt), i1 = i0 + 32 * 128;
            if (Sfin) { Sfin[i0] = scr[ch] * S0[i0] + a0[g]; Sfin[i1] = scr[ch + 32] * S0[i1] + a1[g]; }
            else { Uout[i0] = a0[g]; Uout[i1] = a1[g]; } }
    }
    LDS_WAIT(); asm volatile("" ::: "memory");
}
__device__ __forceinline__ void gla_scan(const Args& args, Frame& F) {
    const int nthr = F.G * NWAVES * 64;
    for (int e = F.vcu * NWAVES * 64 + F.tid; e < 16 * 8192; e += nthr) {
        const int bh = e >> 13, idx = e & 8191, ch = idx >> 7;
        float* p = F_Ubuf + ((size_t)bh * 64 << 13) + idx; const float* d = F_Dbuf + (size_t)bh * 64 * 64 + ch;
        float S = 0.f;
        for (int c0 = 0; c0 < 64; c0 += 8) {
            float u[8], dd[8];
#pragma unroll
            for (int i = 0; i < 8; ++i) { u[i] = p[(size_t)(c0 + i) << 13]; dd[i] = d[(c0 + i) * 64]; }
#pragma unroll
            for (int i = 0; i < 8; ++i) { p[(size_t)(c0 + i) << 13] = S; S = dd[i] * S + u[i]; }
        }
        F.out[O_GP + (size_t)bh * 8192 + idx] = S;
    }
}
template <int NTOK>
__device__ __forceinline__ void gla_out_item(const Args& args, Frame& F, int row0, int h, const float* Sprev, LAS unsigned char* scrb) {
    const int lane = F.lane, r = lane & 31, hi = lane >> 5;
    bf16_t* zr = F_Z + (size_t)row0 * LDZ;
    LAS bf16_t* qs = (LAS bf16_t*)scrb; LAS bf16_t* ksm = qs + 64 * 72;
    {
        const float bg = args.in[I_BGK][64 * h + lane]; float G = 0.f;
#pragma unroll 8
        for (int t = 0; t < NTOK; ++t) { unsigned lb = (unsigned)lane; LAUNDER(lb); const bf16_t* zt = zr + (lb + (unsigned)(t * LDZ + 64 * h));
            const float x = bf2f(zt[ZGK]) + bg; G += logsig16(x);
            const float q = bf2f(zt[ZQB]), k = bf2f(zt[ZKB]);
            qs[t * 72 + lane] = f2bf(q * __expf(G) * 0.125f); ksm[t * 72 + lane] = f2bf(k * __expf(-G)); }
    }
    LDS_WAIT(); asm volatile("" ::: "memory");
    float gg[4];
#pragma unroll
    for (int nt = 0; nt < 4; ++nt) gg[nt] = args.in[I_GGLA][32 * nt + r];
#pragma unroll 1
    for (int tt = 0; tt < NTOK / 32; ++tt) {
        f32x16 o[4];
#pragma unroll
        for (int nt = 0; nt < 4; ++nt) o[nt] = f32x16{};
        bf16x8 qf[4];
#pragma unroll
        for (int ks = 0; ks < 4; ++ks) qf[ks] = *(const LAS bf16x8*)(qs + (32 * tt + r) * 72 + 16 * ks + 8 * hi);
#pragma unroll
        for (int ks = 0; ks < 4; ++ks)
#pragma unroll
            for (int nt = 0; nt < 4; ++nt) {
                float sv[8]; unsigned lb = (unsigned)(8 * hi * 128 + r); LAUNDER(lb);
#pragma unroll
                for (int j = 0; j < 8; ++j) sv[j] = Sprev[lb + (unsigned)((16 * ks + j) * 128 + 32 * nt)];
                const bf16x8 sf = pack8(sv[0], sv[1], sv[2], sv[3], sv[4], sv[5], sv[6], sv[7]);
                o[nt] = __builtin_amdgcn_mfma_f32_32x32x16_bf16(qf[ks], sf, o[nt], 0, 0, 0);
                asm volatile("" ::: "memory");
            }
        for (int st = 0; st <= tt; ++st) {
            f32x16 X = f32x16{};
#pragma unroll
            for (int ks = 0; ks < 4; ++ks) { const bf16x8 kf = *(const LAS bf16x8*)(ksm + (32 * st + r) * 72 + 16 * ks + 8 * hi);
                X = __builtin_amdgcn_mfma_f32_32x32x16_bf16(kf, qf[ks], X, 0, 0, 0); }
            if (st == tt) {
#pragma unroll
                for (int g = 0; g < 16; ++g) if (crow(g, hi) > r) X[g] = 0.f;
            }
#pragma unroll
            for (int s2 = 0; s2 < 2; ++s2) {
                const bf16x8 pa = pack8(X[8 * s2], X[8 * s2 + 1], X[8 * s2 + 2], X[8 * s2 + 3], X[8 * s2 + 4], X[8 * s2 + 5], X[8 * s2 + 6], X[8 * s2 + 7]);
#pragma unroll
                for (int nt = 0; nt < 4; ++nt) {
                    float vv[8]; unsigned lb = (unsigned)((32 * st + 4 * hi) * LDZ + r); LAUNDER(lb);
#pragma unroll
                    for (int j = 0; j < 8; ++j) vv[j] = bf2f(zr[lb + (unsigned)((16 * s2 + 8 * (j >> 2) + (j & 3)) * LDZ + ZVB + 128 * h + 32 * nt)]);
                    const bf16x8 vf = pack8(vv[0], vv[1], vv[2], vv[3], vv[4], vv[5], vv[6], vv[7]);
                    o[nt] = __builtin_amdgcn_mfma_f32_32x32x16_bf16(pa, vf, o[nt], 0, 0, 0);
                    asm volatile("" ::: "memory");
                }
            }
        }
#pragma unroll
        for (int g = 0; g < 16; ++g) {
            float ss = (o[0][g] * o[0][g] + o[1][g] * o[1][g]) + (o[2][g] * o[2][g] + o[3][g] * o[3][g]);
            ss += __shfl_xor(ss, 1); ss += __shfl_xor(ss, 2); ss += __shfl_xor(ss, 4); ss += __shfl_xor(ss, 8); ss += __shfl_xor(ss, 16);
            const float rr = 1.0f / sqrtf(ss * (1.f / 128.f) + EPS);
            unsigned lb = (unsigned)((32 * tt + 4 * hi) * LDZ + r); LAUNDER(lb);
            bf16_t* gp = zr + (lb + (unsigned)(((g & 3) + 8 * (g >> 2)) * LDZ + ZGB + 128 * h));
#pragma unroll
            for (int nt = 0; nt < 4; ++nt) { const float sgv = bf2f(gp[32 * nt]); gp[32 * nt] = f2bf((o[nt][g] * rr) * gg[nt] * sgv); }
        }
    }
    LDS_WAIT(); asm volatile("" ::: "memory");
}

__device__ __forceinline__ float gelu_tanh(float x) { const float u = 0.7978845608028654f * (x + 0.044715f * x * x * x); return x * frcp(1.0f + fexp2(-2.0f * LOG2E * u)); }
__device__ __forceinline__ void unpack8(const u32x4 w, float (&f)[8]) { f[0] = bflo(w.x); f[1] = bfhi(w.x); f[2] = bflo(w.y); f[3] = bfhi(w.y); f[4] = bflo(w.z); f[5] = bfhi(w.z); f[6] = bflo(w.w); f[7] = bfhi(w.w); }
__device__ __forceinline__ void p10_act(const Args& args, Frame& F) {
    const int nthr = F.G * NWAVES * 64;
    bf16_t* U = (bf16_t*)(F.ws + WS_A);
    for (int item = F.vcu * NWAVES * 64 + F.tid; item < 288 * 352; item += nthr) {
        const int blk = item / 352, sl = item % 352, c0 = 8 * sl;
        int row0, nrows; float pa2[8], pa1[8], pg2[8], pg1[8];
        if (blk < 256) { row0 = 64 * blk; nrows = 64;
            if ((blk & 63) == 0) {
#pragma unroll
                for (int j = 0; j < 8; ++j) { pa2[j] = 0.f; pa1[j] = 0.f; pg2[j] = 0.f; pg1[j] = 0.f; }
            } else { const bf16_t* hp = F_halo + (size_t)((blk - 1) * 2) * NUP + c0;
                unpack8(*(const u32x4*)hp, pa2); unpack8(*(const u32x4*)(hp + NUP), pa1); unpack8(*(const u32x4*)(hp + DFF), pg2); unpack8(*(const u32x4*)(hp + NUP + DFF), pg1); }
        } else { const int b = blk - 256; row0 = MP + 32 * b; nrows = 32; const float* sp = args.in[I_SC] + (size_t)b * 2 * NUP + c0;
#pragma unroll
            for (int j = 0; j < 8; ++j) { pa2[j] = sp[j]; pa1[j] = sp[NUP + j]; pg2[j] = sp[DFF + j]; pg1[j] = sp[NUP + DFF + j]; } }
        float wa[3][8], wg[3][8], ba[8], bgv[8];
#pragma unroll
        for (int j = 0; j < 8; ++j) { ba[j] = args.in[I_BDW][c0 + j]; bgv[j] = args.in[I_BDW][DFF + c0 + j];
#pragma unroll
            for (int q = 0; q < 3; ++q) { wa[q][j] = args.in[I_WDW][q * NUP + c0 + j]; wg[q][j] = args.in[I_WDW][q * NUP + DFF + c0 + j]; } }
        for (int t = 0; t < nrows; ++t) {
            bf16_t* up = U + (size_t)(row0 + t) * NUP + c0;
            float ua[8], ug[8]; unpack8(*(const u32x4*)up, ua); unpack8(*(const u32x4*)(up + DFF), ug);
            float a[8];
#pragma unroll
            for (int j = 0; j < 8; ++j) { const float ya = ba[j] + wa[0][j] * pa2[j] + wa[1][j] * pa1[j] + wa[2][j] * ua[j];
                const float yg = bgv[j] + wg[0][j] * pg2[j] + wg[1][j] * pg1[j] + wg[2][j] * ug[j];
                a[j] = gelu_tanh(ya) * yg; pa2[j] = pa1[j]; pa1[j] = ua[j]; pg2[j] = pg1[j]; pg1[j] = ug[j]; }
            u32x4 w; w.x = cvt_pk_bf16(a[0], a[1]); w.y = cvt_pk_bf16(a[2], a[3]); w.z = cvt_pk_bf16(a[4], a[5]); w.w = cvt_pk_bf16(a[6], a[7]);
            *(u32x4*)up = w;
        }
    }
}

constexpr int NPHASE = 13;
#ifndef MK_N_LAUNCHES
#define MK_N_LAUNCHES 1
#endif
__global__ void __launch_bounds__(NWAVES * 64, 2) mk_fwd(Args args) {
    extern __shared__ __attribute__((aligned(16))) unsigned char lds[];
    Frame F;
    F.lds = (LAS unsigned char*)lds;
    F.tid = threadIdx.x; F.lane = F.tid & 63; F.wave = __builtin_amdgcn_readfirstlane(F.tid >> 6);
    F.G = gridDim.x; { const int bx = blockIdx.x; F.vcu = (F.G % 8 == 0) ? (bx % 8) * (F.G / 8) + bx / 8 : bx; }
    F.out = args.out; F.ws = args.ws;
    unsigned char* ws = args.ws;
    for (int u = F.tid; u < (LDS_BYTES - LDSCTL_OFF) / 4; u += NWAVES * 64) ((LAS unsigned*)(F.lds + LDSCTL_OFF))[u] = 0u;
    __syncthreads();
    unsigned* ctl = (unsigned*)(ws + WS_CTL);
    XcdBarrier bar; bar.bar = ctl + CW_BAR; bar.x = 0; bar.st = nullptr;
    const bool one_launch = (args.ph_hi - args.ph_lo) > 1;
    if (one_launch) bar = xcd_barrier_post(ctl + CW_BAR, (volatile LAS unsigned*)(F.lds + MISC_OFF) + 8);
    const int lo = args.ph_lo, hi = args.ph_hi;
#define IN(k) (lo <= (k) && (k) < hi)
#define SEAM(k) do { if (IN(k) && IN((k) + 1)) xcd_barrier(bar); } while (0)
    LAS unsigned char* wscr = F.lds + F.wave * SCR_PER_WAVE;
    const int gw = F.vcu * NWAVES + F.wave, NGW = F.G * NWAVES;

    if (IN(0)) { p0_prologue(args, F); } SEAM(0);
    if (IN(1)) { p1_rows(args, F); } SEAM(1);
    if (IN(2)) {
        pg8::Gemm g{F_XB, F_Win, 1024, 1024, 1024, 0x7fffffff, 0}; pg8::StaticOrder S; S.init(M, LDZ, F.G, (int)blockIdx.x);
        EpiZ E{F_Z, F.out};
        pg8::gemm_phase<EpiZ, pg8::StaticOrder, true>(F.lds, g, S, E);
    } SEAM(2);
    if (IN(3)) {
        for (int it = gw; it < 5504; it += NGW) {
            if (it < 4352) attn_item(args, F, it, (LAS float*)wscr);
            else if (it < 5376) { const int gi = it - 4352, bh = gi >> 6, c = gi & 63;
                gla_local_item<64>(args, F, (bh >> 2) * SEQ + 64 * c, bh & 3, F_Ubuf + ((size_t)gi << 13), F_Dbuf + (size_t)gi * 64, nullptr, nullptr, (LAS float*)wscr); }
            else { const int sb = it - 5376, b = sb >> 2, h = sb & 3;
                gla_local_item<32>(args, F, MP + 32 * b, h, nullptr, nullptr, args.in[I_SG] + ((size_t)sb << 13), F.out + O_GS + ((size_t)sb << 13), (LAS float*)wscr); }
        }
    } SEAM(3);
    if (IN(4)) { gla_scan(args, F); } SEAM(4);
    if (IN(5)) {
        for (int it = gw; it < 1152; it += NGW) {
            if (it < 1024) { const int bh = it >> 6, c = it & 63; gla_out_item<64>(args, F, (bh >> 2) * SEQ + 64 * c, bh & 3, F_Ubuf + ((size_t)it << 13), wscr); }
            else { const int sb = it - 1024; gla_out_item<32>(args, F, MP + 32 * (sb >> 2), sb & 3, args.in[I_SG] + ((size_t)sb << 13), wscr); }
        }
    } SEAM(5);
    if (IN(6)) {
        pg8::Gemm g{F_Z, F_Wbr, LDZ, 1024, 1024, 8, (long)(ZGB - 512) * 2}; pg8::StaticOrder S; S.init(M, 1024, F.G, (int)blockIdx.x);
        EpiMerge E{F_Z, F_XB};
        pg8::gemm_phase<EpiMerge, pg8::StaticOrder, true>(F.lds, g, S, E);
    } SEAM(6);
    if (IN(7)) {
        pg8::Gemm g{F_XB, F_Wout, 1024, 1024, 1024, 0x7fffffff, 0}; pg8::StaticOrder S; S.init(M, 1024, F.G, (int)blockIdx.x);
        pg8::EpiF32 E{F.out + O_Y, 1024};
        pg8::gemm_phase<pg8::EpiF32, pg8::StaticOrder, true>(F.lds, g, S, E);
    } SEAM(7);
    if (IN(8)) { p8_rows(args, F); } SEAM(8);
    if (IN(9)) {
        pg8::Gemm g{F_XB, F_Wup, 1024, 1024, 1024, 0x7fffffff, 0}; pg8::StaticOrder S; S.init(M, NUP, F.G, (int)blockIdx.x);
        EpiU E{(bf16_t*)(ws + WS_A), F_halo, F.out};
        pg8::gemm_phase<EpiU, pg8::StaticOrder, true>(F.lds, g, S, E);
    } SEAM(9);
    if (IN(10)) { p10_act(args, F); } SEAM(10);
    if (IN(11)) {
        pg8::Gemm g{(const bf16_t*)(ws + WS_A), F_Wdn, NUP, DFF, DFF, 0x7fffffff, 0}; pg8::StaticOrder S; S.init(M, 1024, F.G, (int)blockIdx.x);
        pg8::EpiF32 E{(float*)(ws + WS_A) + 1408, DFF};
        pg8::gemm_phase<pg8::EpiF32, pg8::StaticOrder, true>(F.lds, g, S, E);
    } SEAM(11);
    if (IN(12)) { p12_rows(args, F); }
#undef IN
#undef SEAM
}

extern "C" void kernel_launch(void* const* d_in, const int* in_sizes, int n_in, void* d_out, int out_size, void* d_ws, size_t ws_size, hipStream_t stream) {
    static int grid = 0;
    if (grid == 0) {
        if (n_in != 26 || in_sizes[0] != MP * DM || out_size != (int)O_END || ws_size < WS_END) {
            fprintf(stderr, "kernel_launch: shape mismatch: n_in %d in0 %d out %d ws %zu (need %zu)\n", n_in, n_in > 0 ? in_sizes[0] : -1, out_size, ws_size, (size_t)WS_END); grid = -1; return; }
        int dev = 0, cus = 0;
        if (hipGetDevice(&dev) != hipSuccess || hipDeviceGetAttribute(&cus, hipDeviceAttributeMultiprocessorCount, dev) != hipSuccess) { grid = -1; return; }
        if (hipFuncSetAttribute((const void*)mk_fwd, hipFuncAttributeMaxDynamicSharedMemorySize, LDS_BYTES) != hipSuccess) { fprintf(stderr, "kernel_launch: hipFuncSetAttribute failed\n"); grid = -1; return; }
        int per_cu = 0;
        if (hipOccupancyMaxActiveBlocksPerMultiprocessor(&per_cu, (const void*)mk_fwd, NWAVES * 64, LDS_BYTES) != hipSuccess || per_cu < 1)
            fprintf(stderr, "kernel_launch: note: occupancy query reports %d workgroups per CU\n", per_cu);
        (void)hipGetLastError();
        grid = cus;
    }
    if (grid < 0) return;
    if (hipMemsetAsync((char*)d_ws + WS_CTL, 0, CTL_ZERO_BYTES, stream) != hipSuccess) return;
    Args a{};
    for (int i = 0; i < 26; ++i) a.in[i] = (const float*)d_in[i];
    a.out = (float*)d_out; a.ws = (unsigned char*)d_ws;
#if MK_N_LAUNCHES == 1
    a.ph_lo = 0; a.ph_hi = NPHASE;
    hipLaunchKernelGGL(mk_fwd, dim3(grid), dim3(NWAVES * 64), LDS_BYTES, stream, a);
#else
    for (int p = 0; p < NPHASE; ++p) { a.ph_lo = p; a.ph_hi = p + 1; hipLaunchKernelGGL(mk_fwd, dim3(grid), dim3(NWAVES * 64), LDS_BYTES, stream, a); }
#endif
}
```

```cpp
#include <hip/hip_runtime.h>
#include <cstdio>
#include <cstdint>

#define LAS __attribute__((address_space(3)))
#define GAS __attribute__((address_space(1)))
typedef unsigned short bf16_t;
typedef short bf16x8 __attribute__((ext_vector_type(8)));
typedef float f32x4 __attribute__((ext_vector_type(4)));
typedef float f32x2 __attribute__((ext_vector_type(2)));
typedef float f32x16 __attribute__((ext_vector_type(16)));
typedef unsigned u32x4 __attribute__((ext_vector_type(4)));
typedef unsigned u32x2 __attribute__((ext_vector_type(2)));

constexpr int DM = 1024, SEQ = 4096, NBP = 4, NBS = 32, SSEQ = 32;
constexpr int MP = NBP * SEQ, MS = NBS * SSEQ, M = MP + MS;
constexpr int LDZ = 5376;
constexpr int ZQ = 0, ZK = 512, ZV = 1024, ZQB = 1536, ZKB = 1792, ZVB = 2048, ZGB = 2560, ZGK = 3072, ZGA = 3328, ZGT = 4352;
constexpr int NUP = 5632, DFF = 2816, DIN = 5136;
constexpr float EPS = 1e-6f, LOG2E = 1.4426950408889634f;
constexpr float C2 = 0.125f * LOG2E;
constexpr size_t O_Y = 0, O_KP = 17825792, O_VP = 18874368, O_GP = 19922944, O_CP = 20054016, O_KS = 20099072, O_VS = 20623360, O_GS = 21147648, O_CS = 22196224, O_END = 22556672;

constexpr size_t MiB = 1u << 20;
constexpr size_t WS_CTL = 0, CTL_ZERO_BYTES = 2 * MiB;
constexpr size_t WS_MOD = 1 * MiB;
constexpr size_t WS_WIN = 2 * MiB;
constexpr size_t WS_WBR = WS_WIN + (size_t)LDZ * 1024 * 2;
constexpr size_t WS_WOUT = WS_WBR + 2 * MiB;
constexpr size_t WS_WUP = WS_WOUT + 2 * MiB;
constexpr size_t WS_WDN = WS_WUP + (size_t)NUP * 1024 * 2;
constexpr size_t WS_B = WS_WDN + (size_t)1024 * DFF * 2;
constexpr size_t WS_A = WS_B + (size_t)M * 1024 * 2;
constexpr size_t WS_END = WS_A + (size_t)M * NUP * 2;
constexpr size_t WS_HALO = WS_WIN;
constexpr size_t WS_D = WS_B + 33 * MiB;
static_assert(WS_END <= 256 * MiB, "workspace");
constexpr int CW_TMO = 0, CW_BAR = 4096;

constexpr int RING_BYTES = 131072, SCR_PER_WAVE = 18944, LDSCTL_OFF = 8 * SCR_PER_WAVE, MISC_OFF = LDSCTL_OFF + 320, LDS_BYTES = LDSCTL_OFF + 1024;
static_assert(LDSCTL_OFF >= RING_BYTES && LDS_BYTES <= 163840, "LDS map");
constexpr int NWAVES = 8;

__device__ __forceinline__ float bf2f(bf16_t b) { return __builtin_bit_cast(float, (unsigned)b << 16); }
__device__ __forceinline__ float bflo(unsigned w) { return __builtin_bit_cast(float, w << 16); }
__device__ __forceinline__ float bfhi(unsigned w) { return __builtin_bit_cast(float, w & 0xffff0000u); }
__device__ __forceinline__ unsigned cvt_pk_bf16(float lo, float hi) { unsigned r; asm volatile("v_cvt_pk_bf16_f32 %0, %1, %2" : "=v"(r) : "v"(lo), "v"(hi)); return r; }
__device__ __forceinline__ bf16_t f2bf(float f) { return (bf16_t)(cvt_pk_bf16(f, 0.f) & 0xffffu); }
__device__ __forceinline__ float fexp2(float x) { return __builtin_amdgcn_exp2f(x); }
__device__ __forceinline__ float frcp(float x) { return __builtin_amdgcn_rcpf(x); }
__device__ __forceinline__ float sigmoidf_(float x) { return frcp(1.0f + fexp2(-x * LOG2E)); }
__device__ __forceinline__ float wave_sum(float v) {
#pragma unroll
    for (int o = 1; o < 64; o <<= 1) v += __shfl_xor(v, o);
    return v;
}
__device__ __forceinline__ int crow(int r, int hi) { return (r & 3) + 8 * (r >> 2) + 4 * hi; }
__device__ __forceinline__ bf16x8 pack8(float a0, float a1, float a2, float a3, float a4, float a5, float a6, float a7) {
    u32x4 w; w.x = cvt_pk_bf16(a0, a1); w.y = cvt_pk_bf16(a2, a3); w.z = cvt_pk_bf16(a4, a5); w.w = cvt_pk_bf16(a6, a7);
    return __builtin_bit_cast(bf16x8, w);
}
#define LDS_WAIT() asm volatile("s_waitcnt lgkmcnt(0)" ::: "memory")
#define LAUNDER(x) asm volatile("" : "+v"(x))
#define VM_WAIT() asm volatile("s_waitcnt vmcnt(0)" ::: "memory")

namespace pg8 {
constexpr int BM = 256, BK = 64, HALF = 128, HTB = HALF * BK * 2, STAGE_BYTES = 8 * HTB, NXCD = 8, WGM = 8;
__host__ __device__ __forceinline__ int lds_byte(int r, int c) { const int st = (r >> 4) * 2 + (c >> 5), rr = r & 15, cc = c & 31, ob = rr * 64 + cc * 2; return st * 1024 + (ob ^ (((ob >> 9) & 1) << 5)); }
__host__ __device__ __forceinline__ void stage_rc(int b, int& R, int& C) { const int st = b / 1024, sb = b % 1024, swz = sb ^ (((sb >> 9) & 1) << 5); R = (st >> 1) * 16 + swz / 64; C = (st & 1) * 32 + (swz % 64) / 2; }
__host__ __device__ __forceinline__ int perm32(int rho) { const int n = rho >> 4, i = rho & 15; return 8 * (i >> 2) + 4 * n + (i & 3); }

struct Unit { int pm, pn; };
struct Gemm { const bf16_t* A; const bf16_t* Bt; int lda, ldb, K, ksplit; long ajump; };

struct StaticOrder {
    int nM, nN, nwg, G, c;
    __host__ __device__ void init(int M_, int N_, int G_, int c_) { nM = M_ / BM; nN = N_ / BM; nwg = nM * nN; G = G_; c = c_; }
    __host__ __device__ bool next(int i, Unit& u) const {
        const long L = (long)i * G + c; if (L >= nwg) return false;
        int wgid = (int)L; { const int q = nwg / NXCD, r = nwg % NXCD, xcd = wgid % NXCD, off = wgid / NXCD; wgid = (xcd < r ? xcd * (q + 1) : r * (q + 1) + (xcd - r) * q) + off; }
        const int nig = WGM * nN, gid = wgid / nig, fm = gid * WGM, gsz = (nM - fm) < WGM ? (nM - fm) : WGM;
        u.pm = fm + ((wgid % nig) % gsz); u.pn = (wgid % nig) / gsz; return true;
    }
};

struct EpiF32 {
    static constexpr bool PERM = false, HAS_MID = false;
    float* C; int ldc;
    __device__ __forceinline__ void mid(f32x4 (&)[2][2][4][2], const Unit&, int, int, int, int) const {}
    __device__ __forceinline__ void operator()(const f32x4 (&acc)[2][2][4][2], const Unit& u, int wr, int wc, int fr, int fq) const {
        const int row0 = u.pm * BM + wr * 64 + fr, col0 = u.pn * BM + wc * 32 + 4 * fq;
#pragma unroll
        for (int ai = 0; ai < 2; ++ai)
#pragma unroll
            for (int m = 0; m < 4; ++m) { float* rowp = C + (size_t)(row0 + ai * HALF + m * 16) * ldc + col0;
#pragma unroll
                for (int bj = 0; bj < 2; ++bj)
#pragma unroll
                    for (int n = 0; n < 2; ++n) *(f32x4*)(rowp + bj * HALF + n * 16) = acc[ai][bj][m][n]; }
    }
};

template <class Epi, class Sched, bool ALIGN_EPI>
__device__ __forceinline__ void gemm_phase(LAS unsigned char* lds, const Gemm g, const Sched& S, const Epi& E) {
    const int tid = threadIdx.x, wid = __builtin_amdgcn_readfirstlane(tid >> 6), lane = tid & 63, wr = wid >> 2, wc = wid & 3, fr = lane & 15, fq = lane >> 4;
    const int K = g.K, nt = K / BK;
    unsigned voffA[2], voffB[2];
#pragma unroll
    for (int i = 0; i < 2; ++i) { int R, C; stage_rc(tid * 16 + i * 8192, R, C); const int Rb = Epi::PERM ? ((R & ~31) + perm32(R & 31)) : R;
        voffA[i] = (unsigned)(R * g.lda + C) * 2u; voffB[i] = (unsigned)(Rb * g.ldb + C) * 2u; }
    const size_t kstep = (size_t)(BK * 2);
    const size_t hstepA = (size_t)HALF * g.lda * 2, hstepB = (size_t)HALF * g.ldb * 2, tstepA = 2 * hstepA, tstepB = 2 * hstepB;
    const unsigned ldsw = (unsigned)wid * 1024u;
    const int aoff = lds_byte(wr * 64 + fr, fq * 8), boff = lds_byte(wc * 32 + fr, fq * 8);
#define PG8_SA(b, h) (((b) * 2 + (h)) * HTB)
#define PG8_SB(b, h) ((4 + (b) * 2 + (h)) * HTB)
#define PG8_STAGE(bufoff, gbase, voff) do { _Pragma("unroll") for (int _i = 0; _i < 2; ++_i) \
        __builtin_amdgcn_global_load_lds((const unsigned*)((const char*)(gbase) + (voff)[_i]), (LAS unsigned*)(lds + (bufoff) + ldsw + _i * 8192), 16, 0, 0); } while (0)
#define PG8_LDA(dst, b, h) do { _Pragma("unroll") for (int m = 0; m < 4; ++m) _Pragma("unroll") for (int k = 0; k < 2; ++k) dst[m][k] = *(const LAS bf16x8*)(lds + PG8_SA(b, h) + aoff + m * 2048 + k * 1024); } while (0)
#define PG8_LDB(dst, b, h) do { _Pragma("unroll") for (int n = 0; n < 2; ++n) _Pragma("unroll") for (int k = 0; k < 2; ++k) dst[n][k] = *(const LAS bf16x8*)(lds + PG8_SB(b, h) + boff + n * 2048 + k * 1024); } while (0)
#define PG8_MMA(ai, bj, At, Bt) do { __builtin_amdgcn_s_setprio(1); _Pragma("unroll") for (int m = 0; m < 4; ++m) _Pragma("unroll") for (int n = 0; n < 2; ++n) _Pragma("unroll") for (int k = 0; k < 2; ++k) \
        acc[ai][bj][m][n] = __builtin_amdgcn_mfma_f32_16x16x32_bf16(Bt[n][k], At[m][k], acc[ai][bj][m][n], 0, 0, 0); __builtin_amdgcn_s_setprio(0); } while (0)
#define PG8_WAIT_V(n) asm volatile("s_waitcnt vmcnt(" #n ")" ::: "memory")
#define PG8_WAIT_L(n) asm volatile("s_waitcnt lgkmcnt(" #n ")" ::: "memory")
#define PG8_BAR __builtin_amdgcn_s_barrier()
#define PG8_SCHED __builtin_amdgcn_sched_barrier(0)
#define PG8_KOFF(t) ((size_t)(t) * kstep + ((t) >= g.ksplit ? (size_t)g.ajump : (size_t)0))
    Unit cur, nxt; int ui = 0;
    if (!S.next(0, cur)) return;
    f32x4 acc[2][2][4][2];
#pragma unroll
    for (int a = 0; a < 2; ++a)
#pragma unroll
        for (int b = 0; b < 2; ++b)
#pragma unroll
            for (int m = 0; m < 4; ++m)
#pragma unroll
                for (int n = 0; n < 2; ++n) acc[a][b][m][n] = (f32x4){0.f, 0.f, 0.f, 0.f};
    bf16x8 At[4][2], B0[2][2], B1[2][2];
    const char* cA = (const char*)g.A + (size_t)cur.pm * tstepA; const char* cB = (const char*)g.Bt + (size_t)cur.pn * tstepB;
    PG8_STAGE(PG8_SB(0, 0), cB, voffB); PG8_STAGE(PG8_SB(0, 1), cB + hstepB, voffB); PG8_STAGE(PG8_SA(0, 0), cA, voffA); PG8_STAGE(PG8_SA(0, 1), cA + hstepA, voffA);
    if (wr == 1) PG8_BAR;
    PG8_WAIT_V(2); PG8_BAR;
    PG8_STAGE(PG8_SB(1, 0), cB + kstep, voffB); PG8_STAGE(PG8_SA(1, 0), cA + kstep, voffA); PG8_STAGE(PG8_SB(1, 1), cB + hstepB + kstep, voffB);
    PG8_WAIT_V(6); PG8_BAR;
    for (;;) {
        const bool has_next = S.next(ui + 1, nxt);
        const char* nA = has_next ? (const char*)g.A + (size_t)nxt.pm * tstepA : cA; const char* nB = has_next ? (const char*)g.Bt + (size_t)nxt.pn * tstepB : cB;
        for (int tb = 0; tb < nt;) {
        const int te = (Epi::HAS_MID && tb < g.ksplit && g.ksplit < nt) ? g.ksplit : nt;
        if constexpr (Epi::HAS_MID) { if (tb == g.ksplit) { PG8_SCHED; E.mid(acc, cur, wr, wc, fr, fq); PG8_SCHED; } }
        for (int t = tb; t < te; t += 2) {
            const bool last = (t == nt - 2);
            const char* a1 = cA + PG8_KOFF(t) + kstep;
            const char* a2 = last ? nA : cA + PG8_KOFF(t + 2); const char* b2 = last ? nB : cB + (size_t)(t + 2) * kstep;
            const char* a3 = a2 + kstep; const char* b3 = b2 + kstep;
            PG8_LDB(B0, 0, 0); PG8_LDB(B1, 0, 1); PG8_SCHED; PG8_LDA(At, 0, 0); PG8_STAGE(PG8_SA(1, 1), a1 + hstepA, voffA);
            PG8_WAIT_V(8); PG8_WAIT_L(0); PG8_BAR; PG8_MMA(0, 0, At, B0); PG8_MMA(0, 1, At, B1); PG8_BAR; PG8_SCHED;
            PG8_LDA(At, 0, 1); PG8_STAGE(PG8_SB(0, 0), b2, voffB); PG8_STAGE(PG8_SB(0, 1), b2 + hstepB, voffB); PG8_STAGE(PG8_SA(0, 0), a2, voffA);
            PG8_WAIT_V(8); PG8_WAIT_L(0); PG8_BAR; PG8_MMA(1, 0, At, B0); PG8_MMA(1, 1, At, B1); PG8_BAR; PG8_SCHED;
            PG8_LDB(B0, 1, 0); PG8_LDB(B1, 1, 1); PG8_SCHED; PG8_LDA(At, 1, 0); PG8_STAGE(PG8_SA(0, 1), a2 + hstepA, voffA);
            PG8_WAIT_V(8); PG8_WAIT_L(0); PG8_BAR; PG8_MMA(0, 0, At, B0); PG8_MMA(0, 1, At, B1); PG8_BAR; PG8_SCHED;
            PG8_LDA(At, 1, 1); PG8_STAGE(PG8_SB(1, 0), b3, voffB); PG8_STAGE(PG8_SB(1, 1), b3 + hstepB, voffB); PG8_STAGE(PG8_SA(1, 0), a3, voffA);
            PG8_WAIT_V(8); PG8_WAIT_L(0); PG8_BAR; PG8_MMA(1, 0, At, B0); PG8_MMA(1, 1, At, B1); PG8_BAR; PG8_SCHED;
        }
        tb = te;
        }
        if constexpr (ALIGN_EPI) { if (wr == 0) PG8_BAR; }
        E(acc, cur, wr, wc, fr, fq);
        if (!has_next) break;
#pragma unroll
        for (int a = 0; a < 2; ++a)
#pragma unroll
            for (int b = 0; b < 2; ++b)
#pragma unroll
                for (int m = 0; m < 4; ++m)
#pragma unroll
                    for (int n = 0; n < 2; ++n) acc[a][b][m][n] = (f32x4){0.f, 0.f, 0.f, 0.f};
        cur = nxt; cA = nA; cB = nB; ++ui;
        if constexpr (ALIGN_EPI) { if (wr == 1) PG8_BAR; }
    }
    PG8_WAIT_V(0);
    if constexpr (!ALIGN_EPI) { if (wr == 0) PG8_BAR; }
    PG8_BAR;
#undef PG8_SA
#undef PG8_SB
#undef PG8_STAGE
#undef PG8_LDA
#undef PG8_LDB
#undef PG8_MMA
#undef PG8_WAIT_V
#undef PG8_WAIT_L
#undef PG8_BAR
#undef PG8_SCHED
#undef PG8_KOFF
}
}

struct EpiZ {
    static constexpr bool PERM = true, HAS_MID = false;
    bf16_t* Z; float* out;
    __device__ __forceinline__ void mid(f32x4 (&)[2][2][4][2], const pg8::Unit&, int, int, int, int) const {}
    __device__ __forceinline__ void operator()(const f32x4 (&acc)[2][2][4][2], const pg8::Unit& u, int wr, int wc, int fr, int fq) const {
        const int pn = u.pn, row0 = u.pm * 256 + wr * 64 + fr, col0 = pn * 256 + wc * 32 + 8 * fq;
        const int mode = (pn < 2) ? 1 : (pn == 10 || pn == 11) ? 2 : (pn >= 13) ? 3 : 0;
        const bool kv = (pn >= 2 && pn <= 5) && (u.pm >= 64 || (u.pm & 15) >= 14);
        float* kvbase = nullptr; int kcol0 = 0;
        if (kv) { kcol0 = (pn & 1) * 256 + wc * 32 + 8 * fq; const bool isv = pn >= 4;
            kvbase = out + (u.pm >= 64 ? (isv ? O_VS : O_KS) : (isv ? O_VP : O_KP)); }
#pragma unroll
        for (int ai = 0; ai < 2; ++ai)
#pragma unroll
            for (int m = 0; m < 4; ++m) { const int row = row0 + ai * 128 + m * 16; bf16_t* rowp = Z + (size_t)row * LDZ + col0;
                size_t kvrow = 0;
                if (kv) { if (u.pm >= 64) kvrow = (size_t)(row - MP) * 512; else { const int b = row >> 12, t = row & 4095; kvrow = (size_t)(b * 512 + (t - 3584)) * 512; } }
#pragma unroll
                for (int bj = 0; bj < 2; ++bj) { f32x4 v0 = acc[ai][bj][m][0], v1 = acc[ai][bj][m][1];
                    if (kv) { float* p = kvbase + kvrow + kcol0 + bj * 128; *(f32x4*)p = v0; *(f32x4*)(p + 4) = v1; }
                    if (mode == 1) { v0 = v0 * C2; v1 = v1 * C2; }
                    else if (mode == 2) {
#pragma unroll
                        for (int j = 0; j < 4; ++j) { v0[j] = v0[j] * sigmoidf_(v0[j]); v1[j] = v1[j] * sigmoidf_(v1[j]); } }
                    else if (mode == 3) {
#pragma unroll
                        for (int j = 0; j < 4; ++j) { v0[j] = sigmoidf_(v0[j]); v1[j] = sigmoidf_(v1[j]); } }
                    u32x4 w; w.x = cvt_pk_bf16(v0[0], v0[1]); w.y = cvt_pk_bf16(v0[2], v0[3]); w.z = cvt_pk_bf16(v1[0], v1[1]); w.w = cvt_pk_bf16(v1[2], v1[3]);
                    *(u32x4*)(rowp + bj * 128) = w; } }
    }
};
struct EpiMerge {
    static constexpr bool PERM = true, HAS_MID = true;
    const bf16_t* Z; bf16_t* O;
    __device__ __forceinline__ void mid(f32x4 (&acc)[2][2][4][2], const pg8::Unit& u, int wr, int wc, int fr, int fq) const {
        const char* zb = (const char*)Z;
        const unsigned o0 = (unsigned)((u.pm * 256 + wr * 64 + fr) * LDZ + u.pn * 256 + wc * 32 + 8 * fq) * 2u;
#pragma unroll
        for (int ai = 0; ai < 2; ++ai)
#pragma unroll
            for (int m = 0; m < 4; ++m)
#pragma unroll
                for (int bj = 0; bj < 2; ++bj) { unsigned ob = o0; LAUNDER(ob); const unsigned o = ob + (unsigned)((ai * 128 + m * 16) * LDZ + bj * 128) * 2u;
                    const u32x4 a = *(const u32x4*)(zb + o + ZGA * 2), b = *(const u32x4*)(zb + o + ZGT * 2);
                    f32x4& v0 = acc[ai][bj][m][0]; f32x4& v1 = acc[ai][bj][m][1];
                    v0[0] *= bflo(a.x) * frcp(bflo(b.x)); v0[1] *= bfhi(a.x) * frcp(bfhi(b.x)); v0[2] *= bflo(a.y) * frcp(bflo(b.y)); v0[3] *= bfhi(a.y) * frcp(bfhi(b.y));
                    v1[0] *= bflo(a.z) * frcp(bflo(b.z)); v1[1] *= bfhi(a.z) * frcp(bfhi(b.z)); v1[2] *= bflo(a.w) * frcp(bflo(b.w)); v1[3] *= bfhi(a.w) * frcp(bfhi(b.w));
                    asm volatile("" : "+v"(v0), "+v"(v1) :: "memory"); }
    }
    __device__ __forceinline__ void operator()(const f32x4 (&acc)[2][2][4][2], const pg8::Unit& u, int wr, int wc, int fr, int fq) const {
        const int row0 = u.pm * 256 + wr * 64 + fr, col0 = u.pn * 256 + wc * 32 + 8 * fq;
#pragma unroll
        for (int ai = 0; ai < 2; ++ai)
#pragma unroll
            for (int m = 0; m < 4; ++m) { const int row = row0 + ai * 128 + m * 16; const bf16_t* zp = Z + (size_t)row * LDZ + ZGT + col0; bf16_t* op = O + (size_t)row * 1024 + col0;
#pragma unroll
                for (int bj = 0; bj < 2; ++bj) { const u32x4 b = *(const u32x4*)(zp + bj * 128); const f32x4 v0 = acc[ai][bj][m][0], v1 = acc[ai][bj][m][1];
                    u32x4 w; w.x = cvt_pk_bf16(v0[0] * bflo(b.x), v0[1] * bfhi(b.x)); w.y = cvt_pk_bf16(v0[2] * bflo(b.y), v0[3] * bfhi(b.y));
                    w.z = cvt_pk_bf16(v1[0] * bflo(b.z), v1[1] * bfhi(b.z)); w.w = cvt_pk_bf16(v1[2] * bflo(b.w), v1[3] * bfhi(b.w));
                    *(u32x4*)(op + bj * 128) = w; }
                asm volatile("" ::: "memory"); }
    }
};
struct EpiU {
    static constexpr bool PERM = true, HAS_MID = false;
    bf16_t* U; bf16_t* halo; float* out;
    __device__ __forceinline__ void mid(f32x4 (&)[2][2][4][2], const pg8::Unit&, int, int, int, int) const {}
    __device__ __forceinline__ void operator()(const f32x4 (&acc)[2][2][4][2], const pg8::Unit& u, int wr, int wc, int fr, int fq) const {
        const int row0 = u.pm * 256 + wr * 64 + fr, col0 = u.pn * 256 + wc * 32 + 8 * fq;
#pragma unroll
        for (int ai = 0; ai < 2; ++ai)
#pragma unroll
            for (int m = 0; m < 4; ++m) { const int row = row0 + ai * 128 + m * 16; bf16_t* rowp = U + (size_t)row * NUP + col0;
                const bool is_halo = (row < MP) && ((row & 63) >= 62);
                float* cp = nullptr;
                if (row < MP) { const int t = row & 4095; if (t >= 4094) cp = out + O_CP + (size_t)((row >> 12) * 2 + (t - 4094)) * NUP + col0; }
                else { const int rs = row - MP, t = rs & 31; if (t >= 30) cp = out + O_CS + (size_t)((rs >> 5) * 2 + (t - 30)) * NUP + col0; }
#pragma unroll
                for (int bj = 0; bj < 2; ++bj) { const f32x4 v0 = acc[ai][bj][m][0], v1 = acc[ai][bj][m][1];
                    u32x4 w; w.x = cvt_pk_bf16(v0[0], v0[1]); w.y = cvt_pk_bf16(v0[2], v0[3]); w.z = cvt_pk_bf16(v1[0], v1[1]); w.w = cvt_pk_bf16(v1[2], v1[3]);
                    *(u32x4*)(rowp + bj * 128) = w;
                    if (is_halo) *(u32x4*)(halo + (size_t)((row >> 6) * 2 + (row & 1)) * NUP + col0 + bj * 128) = w;
                    if (cp) { *(f32x4*)(cp + bj * 128) = v0; *(f32x4*)(cp + bj * 128 + 4) = v1; } } }
    }
};

#define XB_TMO      128
#define XB_XCNT(j)  (256  + 64 * (j))
#define XB_XSUB(j)  (1280 + 64 * (j))
#define XB_XGEN(j)  (2304 + 64 * (j))
#define XB_TOP      3328
#define XB_TOPGEN   3392
#define XCD_BAR_WORDS 3456
#define XB_SPIN_CAP (1u << 18)
__device__ __forceinline__ unsigned xb_ld(unsigned* p)              { return __hip_atomic_load(p, __ATOMIC_RELAXED, __HIP_MEMORY_SCOPE_AGENT); }
__device__ __forceinline__ unsigned xb_add(unsigned* p, unsigned v) { return __hip_atomic_fetch_add(p, v, __ATOMIC_RELAXED, __HIP_MEMORY_SCOPE_AGENT); }
__device__ __forceinline__ unsigned xb_xcc_id() { return (unsigned)__builtin_amdgcn_s_getreg((3 << 11) | 20) & 0xFu; }
#define XB_SPIN(cond, bar) do { unsigned _sp = 0; while (cond) { __builtin_amdgcn_s_sleep(1); \
    if ((++_sp & 255u) == 0u) { if (xb_ld(&(bar)[XB_TMO])) break; if (_sp > XB_SPIN_CAP) { atomicAdd(&(bar)[XB_TMO], 1u); break; } } } } while (0)
struct XcdBarrier { unsigned* bar; unsigned x; volatile LAS unsigned* st; };
__device__ __forceinline__ XcdBarrier xcd_barrier_post(unsigned* bar, volatile LAS unsigned* st) {
    XcdBarrier b; b.bar = bar; b.x = xb_xcc_id(); b.st = st;
    if (threadIdx.x == 0) (void)xb_add(&bar[XB_XCNT(b.x)], 1u);
    return b;
}
__device__ __forceinline__ void xcd_barrier_complete(unsigned* bar, unsigned x, unsigned& nloc, unsigned& nx) {
    const unsigned G = gridDim.x * gridDim.y * gridDim.z;
    unsigned sum, cnt, mine, sp = 0u;
    for (;;) {
        sum = 0u; cnt = 0u; mine = 0u;
#pragma unroll
        for (unsigned j = 0; j < 16; ++j) { const unsigned c = xb_ld(&bar[XB_XCNT(j)]); sum += c; cnt += (c > 0u) ? 1u : 0u; mine = (j == x) ? c : mine; }
        if (sum == G) break;
        __builtin_amdgcn_s_sleep(1);
        if ((++sp & 255u) == 0u) { if (xb_ld(&bar[XB_TMO])) break; if (sp > XB_SPIN_CAP) { atomicAdd(&bar[XB_TMO], 1u); break; } }
    }
    nloc = mine > 0u ? mine : 1u; nx = cnt > 0u ? cnt : 1u;
}
__device__ __forceinline__ void xcd_barrier(const XcdBarrier& b) {
    asm volatile("s_waitcnt vmcnt(0)" ::: "memory");
    __syncthreads();
    if (threadIdx.x == 0) {
        unsigned* bar = b.bar;
        __builtin_amdgcn_s_waitcnt(0);
        unsigned nloc = b.st[0], nx = b.st[1];
        if (nloc == 0u) { xcd_barrier_complete(bar, b.x, nloc, nx); b.st[0] = nloc; b.st[1] = nx; }
        const unsigned old = xb_add(&bar[XB_XSUB(b.x)], 1u);
        const unsigned gen = old / nloc;
        if (old + 1u == (gen + 1u) * nloc) {
            __builtin_amdgcn_fence(__ATOMIC_RELEASE, "agent");
            asm volatile("s_waitcnt vmcnt(0)" ::: "memory");
            const unsigned og = xb_add(&bar[XB_TOP], 1u);
            const unsigned tg = og / nx;
            if (og + 1u == (tg + 1u) * nx) xb_add(&bar[XB_TOPGEN], 1u);
            else XB_SPIN(xb_ld(&bar[XB_TOPGEN]) == tg, bar);
            __builtin_amdgcn_fence(__ATOMIC_ACQUIRE, "agent");
            xb_add(&bar[XB_XGEN(b.x)], 1u);
            asm volatile("s_waitcnt vmcnt(0)" ::: "memory");
        } else {
            XB_SPIN(xb_ld(&bar[XB_XGEN(b.x)]) == gen, bar);
            __builtin_amdgcn_fence(__ATOMIC_ACQUIRE, "agent");
            asm volatile("s_waitcnt vmcnt(0)" ::: "memory");
        }
    }
    __syncthreads();
}

struct Args { const float* in[26]; float* out; unsigned char* ws; int ph_lo, ph_hi; };
enum { I_XP = 0, I_XS, I_CK, I_CV, I_SG, I_SC, I_CP, I_CS, I_WADA, I_BADA, I_GPM, I_GQM, I_GPF, I_GQF, I_WIN, I_WGK2, I_BGK, I_RELB, I_GGLA, I_WBRA, I_WBRB, I_WOUT, I_WUP, I_WDW, I_BDW, I_WDN };
struct Frame {
    LAS unsigned char* lds;
    int tid, lane, wave, vcu, G;
    float* out; unsigned char* ws;
};
#define FW(T, off) ((T*)(F.ws + (off)))
#define F_mod FW(float, WS_MOD)
#define F_Win FW(bf16_t, WS_WIN)
#define F_Wbr FW(bf16_t, WS_WBR)
#define F_Wout FW(bf16_t, WS_WOUT)
#define F_Wup FW(bf16_t, WS_WUP)
#define F_Wdn FW(bf16_t, WS_WDN)
#define F_XB FW(bf16_t, WS_B)
#define F_Z FW(bf16_t, WS_A)
#define F_halo FW(bf16_t, WS_HALO)
#define F_Ubuf FW(float, WS_B)
#define F_Dbuf FW(float, WS_D)
__device__ __forceinline__ const float* xrow(const Args& args, int row) { return row < MP ? args.in[I_XP] + (size_t)row * DM : args.in[I_XS] + (size_t)(row - MP) * DM; }
__device__ __forceinline__ int modrow(int row) { return row < MP ? (row >> 12) : NBP + ((row - MP) >> 5); }

__device__ __forceinline__ void p0_transpose_item(const float* W, int ldw, int nblk, bf16_t* WT, int ldt, LAS float* scr, int item, int lane) {
    const int kb = item / nblk, nb = item % nblk, k0 = 64 * kb, n0 = 32 * nb;
#pragma unroll 8
    for (int i = 0; i < 32; ++i) { const int kk = 2 * i + (lane >> 5); scr[kk * 33 + (lane & 31)] = W[(size_t)(k0 + kk) * ldw + n0 + (lane & 31)]; }
    LDS_WAIT(); asm volatile("" ::: "memory");
    const int c = lane & 7;
#pragma unroll
    for (int j = 0; j < 4; ++j) { const int n = (lane >> 3) + 8 * j; const LAS float* s = scr + (8 * c) * 33 + n;
        u32x4 o; o.x = cvt_pk_bf16(s[0 * 33], s[1 * 33]); o.y = cvt_pk_bf16(s[2 * 33], s[3 * 33]); o.z = cvt_pk_bf16(s[4 * 33], s[5 * 33]); o.w = cvt_pk_bf16(s[6 * 33], s[7 * 33]);
        *(GAS u32x4*)(WT + (size_t)(n0 + n) * ldt + k0 + 8 * c) = o; }
    LDS_WAIT(); asm volatile("" ::: "memory");
}
__device__ __forceinline__ void p0_fold_item(const Args& args, const Frame& F, LAS float* scr, int item, int lane) {
    const int kb = item / 8, nb = item % 8, k0 = 64 * kb, n0 = 32 * nb;
    float wg[16];
#pragma unroll
    for (int r = 0; r < 16; ++r) wg[r] = args.in[I_WGK2][r * 256 + n0 + (lane & 31)];
#pragma unroll 4
    for (int i = 0; i < 32; ++i) { const int kk = 2 * i + (lane >> 5); const f32x4* wr_ = (const f32x4*)(args.in[I_WIN] + (size_t)(k0 + kk) * DIN + 3072);
        float s = 0.f;
#pragma unroll
        for (int q = 0; q < 4; ++q) { const f32x4 v = wr_[q]; s += v[0] * wg[4 * q] + v[1] * wg[4 * q + 1] + v[2] * wg[4 * q + 2] + v[3] * wg[4 * q + 3]; }
        scr[kk * 33 + (lane & 31)] = s; }
    LDS_WAIT(); asm volatile("" ::: "memory");
    const int c = lane & 7;
#pragma unroll
    for (int j = 0; j < 4; ++j) { const int n = (lane >> 3) + 8 * j; const LAS float* s = scr + (8 * c) * 33 + n;
        u32x4 o; o.x = cvt_pk_bf16(s[0 * 33], s[1 * 33]); o.y = cvt_pk_bf16(s[2 * 33], s[3 * 33]); o.z = cvt_pk_bf16(s[4 * 33], s[5 * 33]); o.w = cvt_pk_bf16(s[6 * 33], s[7 * 33]);
        *(GAS u32x4*)(F_Win + (size_t)(ZGK + n0 + n) * 1024 + k0 + 8 * c) = o; }
    LDS_WAIT(); asm volatile("" ::: "memory");
}
__device__ __forceinline__ void p0_ada_item(const Args& args, const Frame& F, int item, int lane) {
    const int g = item % 96, kc = item / 96, j = 64 * g + lane, k0 = 64 * kc;
    float w[64];
#pragma unroll
    for (int kk = 0; kk < 64; ++kk) w[kk] = args.in[I_WADA][(size_t)(k0 + kk) * 6144 + j];
    const float bias = (kc == 0) ? args.in[I_BADA][j] : 0.f;
    for (int b = 0; b < NBP + NBS; ++b) {
        const float cvv = (b < NBP) ? args.in[I_CP][b * DM + k0 + lane] : args.in[I_CS][(b - NBP) * DM + k0 + lane];
        const float s = cvv * sigmoidf_(cvv);
        float a = bias;
#pragma unroll
        for (int kk = 0; kk < 64; ++kk) a += __builtin_bit_cast(float, __builtin_amdgcn_readlane(__builtin_bit_cast(int, s), kk)) * w[kk];
        atomicAdd(F_mod + (size_t)b * 6144 + j, a);
    }
}
__device__ __forceinline__ void p0_prologue(const Args& args, Frame& F) {
    LAS float* scr = (LAS float*)(F.lds + F.wave * SCR_PER_WAVE);
    const int gw = F.vcu * NWAVES + F.wave, NGW = F.G * NWAVES;
    constexpr int I_ADA = 96 * 16, I_IN1 = 16 * 96, I_IN2 = 16 * 64, I_FOLD = 16 * 8, I_BRA = 8 * 32, I_BRB = 8 * 32, I_OUT = 16 * 32, I_UP = 16 * 176, I_DN = 44 * 32;
    constexpr int NITEMS = I_ADA + I_IN1 + I_IN2 + I_FOLD + I_BRA + I_BRB + I_OUT + I_UP + I_DN;
    for (int it = gw; it < NITEMS; it += NGW) {
        int r = it;
        if (r < I_ADA) { p0_ada_item(args, F, r, F.lane); continue; } r -= I_ADA;
        if (r < I_IN1) { p0_transpose_item(args.in[I_WIN], DIN, 96, F_Win, 1024, scr, r, F.lane); continue; } r -= I_IN1;
        if (r < I_IN2) { p0_transpose_item(args.in[I_WIN] + 3088, DIN, 64, F_Win + (size_t)ZGA * 1024, 1024, scr, r, F.lane); continue; } r -= I_IN2;
        if (r < I_FOLD) { p0_fold_item(args, F, scr, r, F.lane); continue; } r -= I_FOLD;
        if (r < I_BRA) { p0_transpose_item(args.in[I_WBRA], 1024, 32, F_Wbr, 1024, scr, r, F.lane); continue; } r -= I_BRA;
        if (r < I_BRB) { p0_transpose_item(args.in[I_WBRB], 1024, 32, F_Wbr + 512, 1024, scr, r, F.lane); continue; } r -= I_BRB;
        if (r < I_OUT) { p0_transpose_item(args.in[I_WOUT], 1024, 32, F_Wout, 1024, scr, r, F.lane); continue; } r -= I_OUT;
        if (r < I_UP) { p0_transpose_item(args.in[I_WUP], NUP, 176, F_Wup, 1024, scr, r, F.lane); continue; } r -= I_UP;
        p0_transpose_item(args.in[I_WDN], 1024, 32, F_Wdn, DFF, scr, r, F.lane);
    }
}

__device__ __forceinline__ void p1_rows(const Args& args, Frame& F) {
    const int gw = F.vcu * NWAVES + F.wave, NGW = F.G * NWAVES;
    for (int row = gw; row < M; row += NGW) {
        const f32x4* xr = (const f32x4*)xrow(args, row) + F.lane;
        const float* md = F_mod + (size_t)modrow(row) * 6144;
        f32x4 v[4]; float ss = 0.f;
#pragma unroll
        for (int j = 0; j < 4; ++j) { v[j] = xr[64 * j]; ss += (v[j].x * v[j].x + v[j].y * v[j].y) + (v[j].z * v[j].z + v[j].w * v[j].w); }
        const float r = 1.0f / sqrtf(wave_sum(ss) * (1.f / DM) + EPS);
        unsigned long long* o8 = (unsigned long long*)(F_XB + (size_t)row * DM) + F.lane;
#pragma unroll
        for (int j = 0; j < 4; ++j) { const int c = 4 * F.lane + 256 * j;
            const f32x4 g = *(const f32x4*)(args.in[I_GPM] + c), sc = *(const f32x4*)(md + 1024 + c), sh = *(const f32x4*)(md + c);
            const f32x4 h = (v[j] * r) * g * (sc + 1.0f) + sh;
            o8[64 * j] = (unsigned long long)cvt_pk_bf16(h.x, h.y) | ((unsigned long long)cvt_pk_bf16(h.z, h.w) << 32); }
    }
}
__device__ __forceinline__ void p8_rows(const Args& args, Frame& F) {
    const int gw = F.vcu * NWAVES + F.wave, NGW = F.G * NWAVES;
    for (int row = gw; row < M; row += NGW) {
        const f32x4* xr = (const f32x4*)xrow(args, row) + F.lane;
        f32x4* yr = (f32x4*)(F.out + O_Y + (size_t)row * DM) + F.lane;
        const float* md = F_mod + (size_t)modrow(row) * 6144;
        f32x4 v[4]; float ss = 0.f;
#pragma unroll
        for (int j = 0; j < 4; ++j) { v[j] = yr[64 * j]; ss += (v[j].x * v[j].x + v[j].y * v[j].y) + (v[j].z * v[j].z + v[j].w * v[j].w); }
        const float r = 1.0f / sqrtf(wave_sum(ss) * (1.f / DM) + EPS);
        float s2 = 0.f;
#pragma unroll
        for (int j = 0; j < 4; ++j) { const int c = 4 * F.lane + 256 * j;
            const f32x4 g = *(const f32x4*)(args.in[I_GQM] + c), gt = *(const f32x4*)(md + 2048 + c), x = xr[64 * j];
            v[j] = x + gt * ((v[j] * r) * g); yr[64 * j] = v[j];
            s2 += (v[j].x * v[j].x + v[j].y * v[j].y) + (v[j].z * v[j].z + v[j].w * v[j].w); }
        const float r2 = 1.0f / sqrtf(wave_sum(s2) * (1.f / DM) + EPS);
        unsigned long long* o8 = (unsigned long long*)(F_XB + (size_t)row * DM) + F.lane;
#pragma unroll
        for (int j = 0; j < 4; ++j) { const int c = 4 * F.lane + 256 * j;
            const f32x4 g = *(const f32x4*)(args.in[I_GPF] + c), sc = *(const f32x4*)(md + 4096 + c), sh = *(const f32x4*)(md + 3072 + c);
            const f32x4 h = (v[j] * r2) * g * (sc + 1.0f) + sh;
            o8[64 * j] = (unsigned long long)cvt_pk_bf16(h.x, h.y) | ((unsigned long long)cvt_pk_bf16(h.z, h.w) << 32); }
    }
}
__device__ __forceinline__ void p12_rows(const Args& args, Frame& F) {
    const int gw = F.vcu * NWAVES + F.wave, NGW = F.G * NWAVES;
    for (int row = gw; row < M; row += NGW) {
        const f32x4* fr_ = (const f32x4*)((const float*)(F.ws + WS_A) + (size_t)row * DFF + 1408) + F.lane;
        f32x4* yr = (f32x4*)(F.out + O_Y + (size_t)row * DM) + F.lane;
        const float* md = F_mod + (size_t)modrow(row) * 6144;
        f32x4 v[4]; float ss = 0.f;
#pragma unroll
        for (int j = 0; j < 4; ++j) { v[j] = fr_[64 * j]; ss += (v[j].x * v[j].x + v[j].y * v[j].y) + (v[j].z * v[j].z + v[j].w * v[j].w); }
        const float r = 1.0f / sqrtf(wave_sum(ss) * (1.f / DM) + EPS);
#pragma unroll
        for (int j = 0; j < 4; ++j) { const int c = 4 * F.lane + 256 * j;
            const f32x4 g = *(const f32x4*)(args.in[I_GQF] + c), gt = *(const f32x4*)(md + 5120 + c);
            yr[64 * j] = yr[64 * j] + gt * ((v[j] * r) * g); }
    }
}

struct AttnState { float m, l; f32x16 o0, o1; };
__device__ __forceinline__ float pl_max(float m) { auto rr = __builtin_amdgcn_permlane32_swap(__float_as_uint(m), __float_as_uint(m), false, false); return fmaxf(__uint_as_float(rr[0]), __uint_as_float(rr[1])); }
__device__ __forceinline__ float pl_sum(float m) { auto rr = __builtin_amdgcn_permlane32_swap(__float_as_uint(m), __float_as_uint(m), false, false); return __uint_as_float(rr[0]) + __uint_as_float(rr[1]); }
template <int SRC, int NKH>
__device__ __forceinline__ void attn_tile(AttnState& st, const bf16x8 (&qr)[4], const void* kb, const void* vb, int pitch, int off, int iq, LAS float* scr, int r, int hi) {
    f32x16 p[NKH];
#pragma unroll
    for (int kh = 0; kh < NKH; ++kh) {
        p[kh] = f32x16{};
#pragma unroll
        for (int ks = 0; ks < 4; ++ks) {
            bf16x8 kf;
            unsigned kl = (unsigned)(r * pitch + 8 * hi); LAUNDER(kl);
            if (SRC == 0) kf = *(const bf16x8*)((const bf16_t*)kb + (kl + (unsigned)(32 * kh * pitch + 16 * ks)));
            else { const f32x4* pp = (const f32x4*)((const float*)kb + (kl + (unsigned)(32 * kh * pitch + 16 * ks))); const f32x4 a = pp[0], b = pp[1]; kf = pack8(a[0], a[1], a[2], a[3], b[0], b[1], b[2], b[3]); }
            p[kh] = __builtin_amdgcn_mfma_f32_32x32x16_bf16(kf, qr[ks], p[kh], 0, 0, 0);
        }
    }
    if (off >= 191) { const float bc = scr[256];
#pragma unroll
        for (int kh = 0; kh < NKH; ++kh)
#pragma unroll
            for (int g = 0; g < 16; ++g) p[kh][g] += bc;
    } else {
#pragma unroll
        for (int kh = 0; kh < NKH; ++kh)
#pragma unroll
            for (int g = 0; g < 16; ++g) { int rel = iq - (32 * kh + crow(g, hi)) + off; rel = rel < -128 ? -128 : (rel > 128 ? 128 : rel); p[kh][g] += scr[rel + 128]; }
    }
    float mx = p[0][0];
#pragma unroll
    for (int kh = 0; kh < NKH; ++kh)
#pragma unroll
        for (int g = 0; g < 16; ++g) mx = fmaxf(mx, p[kh][g]);
    mx = pl_max(mx);
    const float mn = fmaxf(st.m, mx), alpha = fexp2(st.m - mn);
    float ps = 0.f;
#pragma unroll
    for (int kh = 0; kh < NKH; ++kh)
#pragma unroll
        for (int g = 0; g < 16; ++g) { p[kh][g] = fexp2(p[kh][g] - mn); ps += p[kh][g]; }
    st.l = st.l * alpha + ps; st.m = mn;
    if (hi == 0) scr[272 + r] = alpha;
    LDS_WAIT(); asm volatile("" ::: "memory");
#pragma unroll
    for (int g = 0; g < 16; ++g) { const float a = scr[272 + crow(g, hi)]; st.o0[g] *= a; st.o1[g] *= a; }
#pragma unroll
    for (int kh = 0; kh < NKH; ++kh)
#pragma unroll
        for (int s2 = 0; s2 < 2; ++s2) {
            const bf16x8 pa = pack8(p[kh][8 * s2], p[kh][8 * s2 + 1], p[kh][8 * s2 + 2], p[kh][8 * s2 + 3], p[kh][8 * s2 + 4], p[kh][8 * s2 + 5], p[kh][8 * s2 + 6], p[kh][8 * s2 + 7]);
#pragma unroll
            for (int nt = 0; nt < 2; ++nt) {
                float vv[8]; unsigned lb = (unsigned)(4 * hi * pitch + r); LAUNDER(lb);
#pragma unroll
                for (int j = 0; j < 8; ++j) { const unsigned idx = lb + (unsigned)((32 * kh + 16 * s2 + 8 * (j >> 2) + (j & 3)) * pitch + 32 * nt);
                    if (SRC == 0) vv[j] = bf2f(((const bf16_t*)vb)[idx]); else vv[j] = ((const float*)vb)[idx]; }
                const bf16x8 vf = pack8(vv[0], vv[1], vv[2], vv[3], vv[4], vv[5], vv[6], vv[7]);
                if (nt == 0) st.o0 = __builtin_amdgcn_mfma_f32_32x32x16_bf16(pa, vf, st.o0, 0, 0, 0); else st.o1 = __builtin_amdgcn_mfma_f32_32x32x16_bf16(pa, vf, st.o1, 0, 0, 0);
                asm volatile("" ::: "memory");
            }
        }
    LDS_WAIT(); asm volatile("" ::: "memory");
}
__device__ __forceinline__ void attn_item(const Args& args, Frame& F, int item, LAS float* scr) {
    const int lane = F.lane, r = lane & 31, hi = lane >> 5;
    int b, c = 0, h, qh = 0; bool sample = item >= 4096;
    if (!sample) { qh = item & 1; h = (item >> 1) & 7; c = (item >> 4) & 63; b = item >> 10; } else { const int s = item - 4096; h = s & 7; b = s >> 3; }
    for (int i = lane; i < 257; i += 64) scr[i] = args.in[I_RELB][h * 257 + i] * LOG2E;
    const int rowq0 = sample ? MP + 32 * b : b * SEQ + 64 * c + 32 * qh;
    bf16x8 qr[4];
#pragma unroll
    for (int ks = 0; ks < 4; ++ks) qr[ks] = *(const bf16x8*)(F_Z + (size_t)(rowq0 + r) * LDZ + ZQ + 64 * h + 16 * ks + 8 * hi);
    AttnState st; st.m = -1e30f; st.l = 0.f; st.o0 = f32x16{}; st.o1 = f32x16{};
    const int iq = 32 * qh + r;
    LDS_WAIT(); asm volatile("" ::: "memory");
    if (!sample) {
        for (int jb = (c >= 8 ? 0 : 8 - c); jb <= 8; ++jb) { const size_t key0 = (size_t)b * SEQ + 64 * (c - 8 + jb);
            attn_tile<0, 2>(st, qr, F_Z + key0 * LDZ + ZK + 64 * h, F_Z + key0 * LDZ + ZV + 64 * h, LDZ, (8 - jb) * 64, iq, scr, r, hi); }
    } else {
        for (int jt = 0; jt < 8; ++jt) { const size_t e0 = ((size_t)(b * 512 + 64 * jt) * 8 + h) * 64;
            attn_tile<1, 2>(st, qr, args.in[I_CK] + e0, args.in[I_CV] + e0, 512, 512 - 64 * jt, iq, scr, r, hi); }
        const size_t key0 = (size_t)MP + 32 * b;
        attn_tile<0, 1>(st, qr, F_Z + key0 * LDZ + ZK + 64 * h, F_Z + key0 * LDZ + ZV + 64 * h, LDZ, 0, iq, scr, r, hi);
    }
    const float lt = pl_sum(st.l);
    if (hi == 0) scr[304 + r] = lt;
    LDS_WAIT(); asm volatile("" ::: "memory");
#pragma unroll
    for (int g = 0; g < 16; ++g) { const int q = crow(g, hi); const float inv = frcp(scr[304 + q]);
        unsigned lb = (unsigned)(4 * hi * LDZ + r); if ((g & 3) == 0) LAUNDER(lb);
        bf16_t* op = F_Z + (size_t)rowq0 * LDZ + (lb + (unsigned)(((g & 3) + 8 * (g >> 2)) * LDZ + ZQ + 64 * h));
        op[0] = f2bf(st.o0[g] * inv); op[32] = f2bf(st.o1[g] * inv); }
    LDS_WAIT(); asm volatile("" ::: "memory");
}

typedef short v4i16_t __attribute__((ext_vector_type(4)));
typedef short s16x4 __attribute__((ext_vector_type(4)));
__device__ __forceinline__ s16x4 vtr(const LAS unsigned char* p) { return __builtin_bit_cast(s16x4, __builtin_amdgcn_ds_read_tr16_b64_v4i16((LAS v4i16_t*)p)); }
__device__ __forceinline__ void attn_tile_lds(AttnState& st, const bf16x8 (&qr)[4], const LAS unsigned char* Kb, const LAS unsigned char* Vb, int off, int iq, LAS float* scr, int r, int hi, int vlane) {
    f32x16 p[2];
#pragma unroll
    for (int kh = 0; kh < 2; ++kh) {
        p[kh] = f32x16{};
#pragma unroll
        for (int ks = 0; ks < 4; ++ks) {
            const bf16x8 kf = *(const LAS bf16x8*)(Kb + (2 * ks + hi) * 1024 + (32 * kh + r) * 16);
            p[kh] = __builtin_amdgcn_mfma_f32_32x32x16_bf16(kf, qr[ks], p[kh], 0, 0, 0);
        }
    }
    if (off >= 191) { const float bc = scr[256];
#pragma unroll
        for (int kh = 0; kh < 2; ++kh)
#pragma unroll
            for (int g = 0; g < 16; ++g) p[kh][g] += bc;
    } else {
#pragma unroll
        for (int kh = 0; kh < 2; ++kh)
#pragma unroll
            for (int g = 0; g < 16; ++g) { int rel = iq - (32 * kh + crow(g, hi)) + off; rel = rel < -128 ? -128 : (rel > 128 ? 128 : rel); p[kh][g] += scr[rel + 128]; }
    }
    float mx = p[0][0];
#pragma unroll
    for (int kh = 0; kh < 2; ++kh)
#pragma unroll
        for (int g = 0; g < 16; ++g) mx = fmaxf(mx, p[kh][g]);
    mx = pl_max(mx);
    const float mn = fmaxf(st.m, mx), alpha = fexp2(st.m - mn);
    float ps = 0.f;
#pragma unroll
    for (int kh = 0; kh < 2; ++kh)
#pragma unroll
        for (int g = 0; g < 16; ++g) { p[kh][g] = fexp2(p[kh][g] - mn); ps += p[kh][g]; }
    st.l = st.l * alpha + ps; st.m = mn;
    if (hi == 0) scr[272 + r] = alpha;
    LDS_WAIT(); asm volatile("" ::: "memory");
#pragma unroll
    for (int g = 0; g < 16; ++g) { const float a = scr[272 + crow(g, hi)]; st.o0[g] *= a; st.o1[g] *= a; }
#pragma unroll
    for (int kh = 0; kh < 2; ++kh)
#pragma unroll
        for (int s2 = 0; s2 < 2; ++s2) {
            const bf16x8 pa = pack8(p[kh][8 * s2], p[kh][8 * s2 + 1], p[kh][8 * s2 + 2], p[kh][8 * s2 + 3], p[kh][8 * s2 + 4], p[kh][8 * s2 + 5], p[kh][8 * s2 + 6], p[kh][8 * s2 + 7]);
#pragma unroll
            for (int nt = 0; nt < 2; ++nt) {
                const LAS unsigned char* vp = Vb + vlane + nt * 4096 + (32 * kh + 16 * s2) * 64;
                const s16x4 lo = vtr(vp), hh = vtr(vp + 512);
                const bf16x8 vf = (bf16x8){lo[0], lo[1], lo[2], lo[3], hh[0], hh[1], hh[2], hh[3]};
                if (nt == 0) st.o0 = __builtin_amdgcn_mfma_f32_32x32x16_bf16(pa, vf, st.o0, 0, 0, 0); else st.o1 = __builtin_amdgcn_mfma_f32_32x32x16_bf16(pa, vf, st.o1, 0, 0, 0);
            }
        }
    LDS_WAIT(); asm volatile("" ::: "memory");
}
__device__ __forceinline__ void attn_unit(const Args& args, Frame& F, int b, int c, int hg) {
    const int lane = F.lane, r = lane & 31, hi = lane >> 5, w = F.wave, hs = w >> 1, qh = w & 1, h = 4 * hg + hs;
    LAS float* scr = (LAS float*)(F.lds + RING_BYTES + w * 2560);
    for (int i = lane; i < 257; i += 64) scr[i] = args.in[I_RELB][h * 257 + i] * LOG2E;
    const int rowq0 = b * SEQ + 64 * c + 32 * qh;
    bf16x8 qr[4];
#pragma unroll
    for (int ks = 0; ks < 4; ++ks) qr[ks] = *(const bf16x8*)(F_Z + (size_t)(rowq0 + r) * LDZ + ZQ + 64 * h + 16 * ks + 8 * hi);
    AttnState st; st.m = -1e30f; st.l = 0.f; st.o0 = f32x16{}; st.o1 = f32x16{};
    const int iq = 32 * qh + r;
    const int vlane = ((lane >> 4) & 1) * 32 + (lane & 3) * 8 + (4 * hi + ((lane & 15) >> 2)) * 64;
    const unsigned ksrc = (unsigned)(lane * LDZ + ZK + 8 * w), vsrc = (unsigned)((16 * (w & 3) + (lane >> 2)) * LDZ + ZV + 32 * (w >> 2) + 8 * (lane & 3));
    const int kc0 = c >= 8 ? c - 8 : 0, nst = c - kc0 + 1;
#define ATT_STAGE(s_) do { const bf16_t* zk_ = F_Z + (size_t)(b * SEQ + 64 * (kc0 + (s_))) * LDZ + 256 * hg; LAS unsigned char* d_ = F.lds + ((s_) & 1) * 65536 + w * 1024; \
        _Pragma("unroll") for (int n_ = 0; n_ < 4; ++n_) { \
            __builtin_amdgcn_global_load_lds((const unsigned*)(zk_ + ksrc + 64 * n_), (LAS unsigned*)(d_ + n_ * 16384), 16, 0, 0); \
            __builtin_amdgcn_global_load_lds((const unsigned*)(zk_ + vsrc + 64 * n_), (LAS unsigned*)(d_ + n_ * 16384 + 8192), 16, 0, 0); } } while (0)
    ATT_STAGE(0);
    asm volatile("s_waitcnt vmcnt(0) lgkmcnt(0)" ::: "memory"); __builtin_amdgcn_s_barrier(); asm volatile("" ::: "memory");
    for (int s = 0; s < nst; ++s) {
        if (s + 1 < nst) ATT_STAGE(s + 1);
        const LAS unsigned char* Kb = F.lds + (s & 1) * 65536 + hs * 16384;
        attn_tile_lds(st, qr, Kb, Kb + 8192, (c - (kc0 + s)) * 64, iq, scr, r, hi, vlane);
        asm volatile("s_waitcnt vmcnt(0) lgkmcnt(0)" ::: "memory"); __builtin_amdgcn_s_barrier(); asm volatile("" ::: "memory");
    }
#undef ATT_STAGE
    const float lt = pl_sum(st.l);
    if (hi == 0) scr[304 + r] = lt;
    LDS_WAIT(); asm volatile("" ::: "memory");
#pragma unroll
    for (int g = 0; g < 16; ++g) { const int q = crow(g, hi); const float inv = frcp(scr[304 + q]);
        unsigned lb = (unsigned)(4 * hi * LDZ + r); if ((g & 3) == 0) LAUNDER(lb);
        bf16_t* op = F_Z + (size_t)rowq0 * LDZ + (lb + (unsigned)(((g & 3) + 8 * (g >> 2)) * LDZ + ZQ + 64 * h));
        op[0] = f2bf(st.o0[g] * inv); op[32] = f2bf(st.o1[g] * inv); }
    LDS_WAIT(); asm volatile("" ::: "memory");
}

__device__ __forceinline__ float logsig16(float x) {
    const float ax = fabsf(x); return (fminf(x, 0.f) - __logf(1.0f + __expf(-ax))) * 0.0625f;
}
template <int NTOK>
__device__ __forceinline__ void gla_local_item(const Args& args, Frame& F, int row0, int h, float* Uout, float* Dout, const float* S0, float* Sfin, LAS float* scr) {
    const int lane = F.lane, r = lane & 31, hi = lane >> 5;
    const bf16_t* zr = F_Z + (size_t)row0 * LDZ;
    const float bg = args.in[I_BGK][64 * h + lane];
    float Gt[NTOK]; float G = 0.f;
#pragma unroll
    for (int t = 0; t < NTOK; ++t) { unsigned lb = (unsigned)lane; if ((t & 7) == 0) LAUNDER(lb); const float x = bf2f(zr[lb + (unsigned)(t * LDZ + ZGK + 64 * h)]) + bg; G += logsig16(x); Gt[t] = G; }
    const float Gl = G, Dv = __expf(Gl);
    if (Dout) Dout[lane] = Dv;
    if (Sfin) { scr[lane] = Dv; }
#pragma unroll
    for (int t = 0; t < NTOK; ++t) { unsigned lb = (unsigned)lane; if ((t & 7) == 0) LAUNDER(lb); const float k = bf2f(zr[lb + (unsigned)(t * LDZ + ZKB + 64 * h)]); Gt[t] = k * __expf(Gl - Gt[t]); }
    bf16x8 F0[NTOK / 16], F1[NTOK / 16];
#pragma unroll
    for (int ks = 0; ks < NTOK / 16; ++ks) {
        u32x4 Y, X;
        Y.x = cvt_pk_bf16(Gt[16 * ks + 0], Gt[16 * ks + 1]); Y.y = cvt_pk_bf16(Gt[16 * ks + 2], Gt[16 * ks + 3]); Y.z = cvt_pk_bf16(Gt[16 * ks + 4], Gt[16 * ks + 5]); Y.w = cvt_pk_bf16(Gt[16 * ks + 6], Gt[16 * ks + 7]);
        X.x = cvt_pk_bf16(Gt[16 * ks + 8], Gt[16 * ks + 9]); X.y = cvt_pk_bf16(Gt[16 * ks + 10], Gt[16 * ks + 11]); X.z = cvt_pk_bf16(Gt[16 * ks + 12], Gt[16 * ks + 13]); X.w = cvt_pk_bf16(Gt[16 * ks + 14], Gt[16 * ks + 15]);
        u32x4 A0, A1;
        { auto s = __builtin_amdgcn_permlane32_swap(Y.x, X.x, false, false); A0.x = s[0]; A1.x = s[1]; }
        { auto s = __builtin_amdgcn_permlane32_swap(Y.y, X.y, false, false); A0.y = s[0]; A1.y = s[1]; }
        { auto s = __builtin_amdgcn_permlane32_swap(Y.z, X.z, false, false); A0.z = s[0]; A1.z = s[1]; }
        { auto s = __builtin_amdgcn_permlane32_swap(Y.w, X.w, false, false); A0.w = s[0]; A1.w = s[1]; }
        F0[ks] = __builtin_bit_cast(bf16x8, A0); F1[ks] = __builtin_bit_cast(bf16x8, A1);
    }
    LDS_WAIT(); asm volatile("" ::: "memory");
#pragma unroll 1
    for (int nt = 0; nt < 4; ++nt) {
        f32x16 a0 = f32x16{}, a1 = f32x16{};
#pragma unroll
        for (int ks = 0; ks < NTOK / 16; ++ks) {
            float vv[8]; unsigned lb = (unsigned)(8 * hi * LDZ + r); LAUNDER(lb);
#pragma unroll
            for (int j = 0; j < 8; ++j) vv[j] = bf2f(zr[lb + (unsigned)((16 * ks + j) * LDZ + ZVB + 128 * h + 32 * nt)]);
            const bf16x8 vf = pack8(vv[0], vv[1], vv[2], vv[3], vv[4], vv[5], vv[6], vv[7]);
            a0 = __builtin_amdgcn_mfma_f32_32x32x16_bf16(F0[ks], vf, a0, 0, 0, 0);
            a1 = __builtin_amdgcn_mfma_f32_32x32x16_bf16(F1[ks], vf, a1, 0, 0, 0);
            asm volatile("" ::: "memory");
        }
#pragma unroll
        for (int g = 0; g < 16; ++g) { const int ch = crow(g, hi); unsigned lb = (unsigned)(4 * hi * 128 + r); if ((g & 3) == 0) LAUNDER(lb); const unsigned i0 = lb + (unsigned)(((g & 3) + 8 * (g >> 2)) * 128 + 32 * nt), i1 = i0 + 32 * 128;
            if (Sfin) { Sfin[i0] = scr[ch] * S0[i0] + a0[g]; Sfin[i1] = scr[ch + 32] * S0[i1] + a1[g]; }
            else { Uout[i0] = a0[g]; Uout[i1] = a1[g]; } }
    }
    LDS_WAIT(); asm volatile("" ::: "memory");
}
__device__ __forceinline__ void gla_scan(const Args& args, Frame& F) {
    const int nthr = F.G * NWAVES * 64;
    for (int e = F.vcu * NWAVES * 64 + F.tid; e < 16 * 8192; e += nthr) {
        const int bh = e >> 13, idx = e & 8191, ch = idx >> 7;
        float* p = F_Ubuf + ((size_t)bh * 64 << 13) + idx; const float* d = F_Dbuf + (size_t)bh * 64 * 64 + ch;
        float S = 0.f;
        for (int c0 = 0; c0 < 64; c0 += 8) {
            float u[8], dd[8];
#pragma unroll
            for (int i = 0; i < 8; ++i) { u[i] = p[(size_t)(c0 + i) << 13]; dd[i] = d[(c0 + i) * 64]; }
#pragma unroll
            for (int i = 0; i < 8; ++i) { p[(size_t)(c0 + i) << 13] = S; S = dd[i] * S + u[i]; }
        }
        F.out[O_GP + (size_t)bh * 8192 + idx] = S;
    }
}
template <int NTOK>
__device__ __forceinline__ void gla_out_item(const Args& args, Frame& F, int row0, int h, const float* Sprev, LAS unsigned char* scrb) {
    const int lane = F.lane, r = lane & 31, hi = lane >> 5;
    bf16_t* zr = F_Z + (size_t)row0 * LDZ;
    LAS bf16_t* qs = (LAS bf16_t*)scrb; LAS bf16_t* ksm = qs + 64 * 72;
    {
        const float bg = args.in[I_BGK][64 * h + lane]; float G = 0.f;
#pragma unroll 8
        for (int t = 0; t < NTOK; ++t) { unsigned lb = (unsigned)lane; LAUNDER(lb); const bf16_t* zt = zr + (lb + (unsigned)(t * LDZ + 64 * h));
            const float x = bf2f(zt[ZGK]) + bg; G += logsig16(x);
            const float q = bf2f(zt[ZQB]), k = bf2f(zt[ZKB]);
            qs[t * 72 + lane] = f2bf(q * __expf(G) * 0.125f); ksm[t * 72 + lane] = f2bf(k * __expf(-G)); }
    }
    LDS_WAIT(); asm volatile("" ::: "memory");
    float gg[4];
#pragma unroll
    for (int nt = 0; nt < 4; ++nt) gg[nt] = args.in[I_GGLA][32 * nt + r];
#pragma unroll 1
    for (int tt = 0; tt < NTOK / 32; ++tt) {
        f32x16 o[4];
#pragma unroll
        for (int nt = 0; nt < 4; ++nt) o[nt] = f32x16{};
        bf16x8 qf[4];
#pragma unroll
        for (int ks = 0; ks < 4; ++ks) qf[ks] = *(const LAS bf16x8*)(qs + (32 * tt + r) * 72 + 16 * ks + 8 * hi);
#pragma unroll
        for (int ks = 0; ks < 4; ++ks)
#pragma unroll
            for (int nt = 0; nt < 4; ++nt) {
                float sv[8]; unsigned lb = (unsigned)(8 * hi * 128 + r); LAUNDER(lb);
#pragma unroll
                for (int j = 0; j < 8; ++j) sv[j] = Sprev[lb + (unsigned)((16 * ks + j) * 128 + 32 * nt)];
                const bf16x8 sf = pack8(sv[0], sv[1], sv[2], sv[3], sv[4], sv[5], sv[6], sv[7]);
                o[nt] = __builtin_amdgcn_mfma_f32_32x32x16_bf16(qf[ks], sf, o[nt], 0, 0, 0);
                asm volatile("" ::: "memory");
            }
        for (int st = 0; st <= tt; ++st) {
            f32x16 X = f32x16{};
#pragma unroll
            for (int ks = 0; ks < 4; ++ks) { const bf16x8 kf = *(const LAS bf16x8*)(ksm + (32 * st + r) * 72 + 16 * ks + 8 * hi);
                X = __builtin_amdgcn_mfma_f32_32x32x16_bf16(kf, qf[ks], X, 0, 0, 0); }
            if (st == tt) {
#pragma unroll
                for (int g = 0; g < 16; ++g) if (crow(g, hi) > r) X[g] = 0.f;
            }
#pragma unroll
            for (int s2 = 0; s2 < 2; ++s2) {
                const bf16x8 pa = pack8(X[8 * s2], X[8 * s2 + 1], X[8 * s2 + 2], X[8 * s2 + 3], X[8 * s2 + 4], X[8 * s2 + 5], X[8 * s2 + 6], X[8 * s2 + 7]);
#pragma unroll
                for (int nt = 0; nt < 4; ++nt) {
                    float vv[8]; unsigned lb = (unsigned)((32 * st + 4 * hi) * LDZ + r); LAUNDER(lb);
#pragma unroll
                    for (int j = 0; j < 8; ++j) vv[j] = bf2f(zr[lb + (unsigned)((16 * s2 + 8 * (j >> 2) + (j & 3)) * LDZ + ZVB + 128 * h + 32 * nt)]);
                    const bf16x8 vf = pack8(vv[0], vv[1], vv[2], vv[3], vv[4], vv[5], vv[6], vv[7]);
                    o[nt] = __builtin_amdgcn_mfma_f32_32x32x16_bf16(pa, vf, o[nt], 0, 0, 0);
                    asm volatile("" ::: "memory");
                }
            }
        }
#pragma unroll
        for (int g = 0; g < 16; ++g) {
            float ss = (o[0][g] * o[0][g] + o[1][g] * o[1][g]) + (o[2][g] * o[2][g] + o[3][g] * o[3][g]);
            ss += __shfl_xor(ss, 1); ss += __shfl_xor(ss, 2); ss += __shfl_xor(ss, 4); ss += __shfl_xor(ss, 8); ss += __shfl_xor(ss, 16);
            const float rr = 1.0f / sqrtf(ss * (1.f / 128.f) + EPS);
            unsigned lb = (unsigned)((32 * tt + 4 * hi) * LDZ + r); LAUNDER(lb);
            bf16_t* gp = zr + (lb + (unsigned)(((g & 3) + 8 * (g >> 2)) * LDZ + ZGB + 128 * h));
#pragma unroll
            for (int nt = 0; nt < 4; ++nt) { const float sgv = bf2f(gp[32 * nt]); gp[32 * nt] = f2bf((o[nt][g] * rr) * gg[nt] * sgv); }
        }
    }
    LDS_WAIT(); asm volatile("" ::: "memory");
}

__device__ __forceinline__ float gelu_tanh(float x) { const float u = 0.7978845608028654f * (x + 0.044715f * x * x * x); return x * frcp(1.0f + fexp2(-2.0f * LOG2E * u)); }
__device__ __forceinline__ void unpack8(const u32x4 w, float (&f)[8]) { f[0] = bflo(w.x); f[1] = bfhi(w.x); f[2] = bflo(w.y); f[3] = bfhi(w.y); f[4] = bflo(w.z); f[5] = bfhi(w.z); f[6] = bflo(w.w); f[7] = bfhi(w.w); }
__device__ __forceinline__ void p10_act(const Args& args, Frame& F) {
    const int nthr = F.G * NWAVES * 64;
    bf16_t* U = (bf16_t*)(F.ws + WS_A);
    for (int item = F.vcu * NWAVES * 64 + F.tid; item < 288 * 352; item += nthr) {
        const int blk = item / 352, sl = item % 352, c0 = 8 * sl;
        int row0, nrows; float pa2[8], pa1[8], pg2[8], pg1[8];
        if (blk < 256) { row0 = 64 * blk; nrows = 64;
            if ((blk & 63) == 0) {
#pragma unroll
                for (int j = 0; j < 8; ++j) { pa2[j] = 0.f; pa1[j] = 0.f; pg2[j] = 0.f; pg1[j] = 0.f; }
            } else { const bf16_t* hp = F_halo + (size_t)((blk - 1) * 2) * NUP + c0;
                unpack8(*(const u32x4*)hp, pa2); unpack8(*(const u32x4*)(hp + NUP), pa1); unpack8(*(const u32x4*)(hp + DFF), pg2); unpack8(*(const u32x4*)(hp + NUP + DFF), pg1); }
        } else { const int b = blk - 256; row0 = MP + 32 * b; nrows = 32; const float* sp = args.in[I_SC] + (size_t)b * 2 * NUP + c0;
#pragma unroll
            for (int j = 0; j < 8; ++j) { pa2[j] = sp[j]; pa1[j] = sp[NUP + j]; pg2[j] = sp[DFF + j]; pg1[j] = sp[NUP + DFF + j]; } }
        float wa[3][8], wg[3][8], ba[8], bgv[8];
#pragma unroll
        for (int j = 0; j < 8; ++j) { ba[j] = args.in[I_BDW][c0 + j]; bgv[j] = args.in[I_BDW][DFF + c0 + j];
#pragma unroll
            for (int q = 0; q < 3; ++q) { wa[q][j] = args.in[I_WDW][q * NUP + c0 + j]; wg[q][j] = args.in[I_WDW][q * NUP + DFF + c0 + j]; } }
        for (int t = 0; t < nrows; ++t) {
            bf16_t* up = U + (size_t)(row0 + t) * NUP + c0;
            float ua[8], ug[8]; unpack8(*(const u32x4*)up, ua); unpack8(*(const u32x4*)(up + DFF), ug);
            float a[8];
#pragma unroll
            for (int j = 0; j < 8; ++j) { const float ya = ba[j] + wa[0][j] * pa2[j] + wa[1][j] * pa1[j] + wa[2][j] * ua[j];
                const float yg = bgv[j] + wg[0][j] * pg2[j] + wg[1][j] * pg1[j] + wg[2][j] * ug[j];
                a[j] = gelu_tanh(ya) * yg; pa2[j] = pa1[j]; pa1[j] = ua[j]; pg2[j] = pg1[j]; pg1[j] = ug[j]; }
            u32x4 w; w.x = cvt_pk_bf16(a[0], a[1]); w.y = cvt_pk_bf16(a[2], a[3]); w.z = cvt_pk_bf16(a[4], a[5]); w.w = cvt_pk_bf16(a[6], a[7]);
            *(u32x4*)up = w;
        }
    }
}

constexpr int NPHASE = 13;
#ifndef MK_N_LAUNCHES
#define MK_N_LAUNCHES 1
#endif
__global__ void __launch_bounds__(NWAVES * 64, 2) mk_fwd(Args args) {
    extern __shared__ __attribute__((aligned(16))) unsigned char lds[];
    Frame F;
    F.lds = (LAS unsigned char*)lds;
    F.tid = threadIdx.x; F.lane = F.tid & 63; F.wave = __builtin_amdgcn_readfirstlane(F.tid >> 6);
    F.G = gridDim.x; { const int bx = blockIdx.x; F.vcu = (F.G % 8 == 0) ? (bx % 8) * (F.G / 8) + bx / 8 : bx; }
    F.out = args.out; F.ws = args.ws;
    unsigned char* ws = args.ws;
    for (int u = F.tid; u < (LDS_BYTES - LDSCTL_OFF) / 4; u += NWAVES * 64) ((LAS unsigned*)(F.lds + LDSCTL_OFF))[u] = 0u;
    __syncthreads();
    unsigned* ctl = (unsigned*)(ws + WS_CTL);
    XcdBarrier bar; bar.bar = ctl + CW_BAR; bar.x = 0; bar.st = nullptr;
    const bool one_launch = (args.ph_hi - args.ph_lo) > 1;
    if (one_launch) bar = xcd_barrier_post(ctl + CW_BAR, (volatile LAS unsigned*)(F.lds + MISC_OFF) + 8);
    const int lo = args.ph_lo, hi = args.ph_hi;
#define IN(k) (lo <= (k) && (k) < hi)
#define SEAM(k) do { if (IN(k) && IN((k) + 1)) xcd_barrier(bar); } while (0)
    LAS unsigned char* wscr = F.lds + F.wave * SCR_PER_WAVE;
    const int gw = F.vcu * NWAVES + F.wave, NGW = F.G * NWAVES;

    if (IN(0)) { p0_prologue(args, F); } SEAM(0);
    if (IN(1)) { p1_rows(args, F); } SEAM(1);
    if (IN(2)) {
        pg8::Gemm g{F_XB, F_Win, 1024, 1024, 1024, 0x7fffffff, 0}; pg8::StaticOrder S; S.init(M, LDZ, F.G, (int)blockIdx.x);
        EpiZ E{F_Z, F.out};
        pg8::gemm_phase<EpiZ, pg8::StaticOrder, true>(F.lds, g, S, E);
    } SEAM(2);
    if (IN(3)) {
        if (F.G == 256) { const int x = F.vcu >> 5, j = F.vcu & 31;
            attn_unit(args, F, x >> 1, j, x & 1); attn_unit(args, F, x >> 1, 63 - j, x & 1);
        } else { for (int u = F.vcu; u < 512; u += F.G) attn_unit(args, F, u >> 7, u & 63, (u >> 6) & 1); }
        for (int it = gw; it < 1152; it += NGW) {
            if (it < 1024) { const int gi = it, bh = gi >> 6, c = gi & 63;
                gla_local_item<64>(args, F, (bh >> 2) * SEQ + 64 * c, bh & 3, F_Ubuf + ((size_t)gi << 13), F_Dbuf + (size_t)gi * 64, nullptr, nullptr, (LAS float*)wscr); }
            else { const int sb = it - 1024, b = sb >> 2, h = sb & 3;
                gla_local_item<32>(args, F, MP + 32 * b, h, nullptr, nullptr, args.in[I_SG] + ((size_t)sb << 13), F.out + O_GS + ((size_t)sb << 13), (LAS float*)wscr); }
        }
    } SEAM(3);
    if (IN(4)) { gla_scan(args, F); } SEAM(4);
    if (IN(5)) {
        for (int it = gw; it < 1408; it += NGW) {
            if (it < 1024) { const int bh = it >> 6, c = it & 63; gla_out_item<64>(args, F, (bh >> 2) * SEQ + 64 * c, bh & 3, F_Ubuf + ((size_t)it << 13), wscr); }
            else if (it < 1152) { const int sb = it - 1024; gla_out_item<32>(args, F, MP + 32 * (sb >> 2), sb & 3, args.in[I_SG] + ((size_t)sb << 13), wscr); }
            else attn_item(args, F, 4096 + (it - 1152), (LAS float*)wscr);
        }
    } SEAM(5);
    if (IN(6)) {
        pg8::Gemm g{F_Z, F_Wbr, LDZ, 1024, 1024, 8, (long)(ZGB - 512) * 2}; pg8::StaticOrder S; S.init(M, 1024, F.G, (int)blockIdx.x);
        EpiMerge E{F_Z, F_XB};
        pg8::gemm_phase<EpiMerge, pg8::StaticOrder, true>(F.lds, g, S, E);
    } SEAM(6);
    if (IN(7)) {
        pg8::Gemm g{F_XB, F_Wout, 1024, 1024, 1024, 0x7fffffff, 0}; pg8::StaticOrder S; S.init(M, 1024, F.G, (int)blockIdx.x);
        pg8::EpiF32 E{F.out + O_Y, 1024};
        pg8::gemm_phase<pg8::EpiF32, pg8::StaticOrder, true>(F.lds, g, S, E);
    } SEAM(7);
    if (IN(8)) { p8_rows(args, F); } SEAM(8);
    if (IN(9)) {
        pg8::Gemm g{F_XB, F_Wup, 1024, 1024, 1024, 0x7fffffff, 0}; pg8::StaticOrder S; S.init(M, NUP, F.G, (int)blockIdx.x);
        EpiU E{(bf16_t*)(ws + WS_A), F_halo, F.out};
        pg8::gemm_phase<EpiU, pg8::StaticOrder, true>(F.lds, g, S, E);
    } SEAM(9);
    if (IN(10)) { p10_act(args, F); } SEAM(10);
    if (IN(11)) {
        pg8::Gemm g{(const bf16_t*)(ws + WS_A), F_Wdn, NUP, DFF, DFF, 0x7fffffff, 0}; pg8::StaticOrder S; S.init(M, 1024, F.G, (int)blockIdx.x);
        pg8::EpiF32 E{(float*)(ws + WS_A) + 1408, DFF};
        pg8::gemm_phase<pg8::EpiF32, pg8::StaticOrder, true>(F.lds, g, S, E);
    } SEAM(11);
    if (IN(12)) { p12_rows(args, F); }
#undef IN
#undef SEAM
}

extern "C" void kernel_launch(void* const* d_in, const int* in_sizes, int n_in, void* d_out, int out_size, void* d_ws, size_t ws_size, hipStream_t stream) {
    static int grid = 0;
    if (grid == 0) {
        if (n_in != 26 || in_sizes[0] != MP * DM || out_size != (int)O_END || ws_size < WS_END) {
            fprintf(stderr, "kernel_launch: shape mismatch: n_in %d in0 %d out %d ws %zu (need %zu)\n", n_in, n_in > 0 ? in_sizes[0] : -1, out_size, ws_size, (size_t)WS_END); grid = -1; return; }
        int dev = 0, cus = 0;
        if (hipGetDevice(&dev) != hipSuccess || hipDeviceGetAttribute(&cus, hipDeviceAttributeMultiprocessorCount, dev) != hipSuccess) { grid = -1; return; }
        if (hipFuncSetAttribute((const void*)mk_fwd, hipFuncAttributeMaxDynamicSharedMemorySize, LDS_BYTES) != hipSuccess) { fprintf(stderr, "kernel_launch: hipFuncSetAttribute failed\n"); grid = -1; return; }
        int per_cu = 0;
        if (hipOccupancyMaxActiveBlocksPerMultiprocessor(&per_cu, (const void*)mk_fwd, NWAVES * 64, LDS_BYTES) != hipSuccess || per_cu < 1)
            fprintf(stderr, "kernel_launch: note: occupancy query reports %d workgroups per CU\n", per_cu);
        (void)hipGetLastError();
        grid = cus;
    }
    if (grid < 0) return;
    if (hipMemsetAsync((char*)d_ws + WS_CTL, 0, CTL_ZERO_BYTES, stream) != hipSuccess) return;
    Args a{};
    for (int i = 0; i < 26; ++i) a.in[i] = (const float*)d_in[i];
    a.out = (float*)d_out; a.ws = (unsigned char*)d_ws;
#if MK_N_LAUNCHES == 1
    a.ph_lo = 0; a.ph_hi = NPHASE;
    hipLaunchKernelGGL(mk_fwd, dim3(grid), dim3(NWAVES * 64), LDS_BYTES, stream, a);
#else
    for (int p = 0; p < NPHASE; ++p) { a.ph_lo = p; a.ph_hi = p + 1; hipLaunchKernelGGL(mk_fwd, dim3(grid), dim3(NWAVES * 64), LDS_BYTES, stream, a); }
#endif
}
```
